# Optimizing an MI355X kernel written in HIP

```python
import math
import jax
import jax.numpy as jnp
from jax import lax
import numpy as np

D_MODEL = 1024
BATCH = 16
SEQ = 256
DEPTH = 2
DEC_BATCH = 4
DEC_SEQ = 4096
PAST_LEN = 256

GRID_W = 64
N_MIXERS = 2
N_GLA_LAYERS = (DEPTH + 1) // 2
N_MLA_LAYERS = DEPTH // 2
D_FF = 2816
MACARON_W = 0.5
N_MOD = 9
EPS = 1e-6

GLA_HEADS = 4
GLA_DK = D_MODEL // 2 // GLA_HEADS
GLA_DV = D_MODEL // GLA_HEADS
GLA_GATE_RANK = 16
GLA_TAU = 16.0
GLA_CHUNK = 64
GLA_QK = GLA_HEADS * GLA_DK
GLA_VV = GLA_HEADS * GLA_DV
GLA_SPLITS = [GLA_QK, 2 * GLA_QK, 2 * GLA_QK + GLA_VV, 2 * GLA_QK + 2 * GLA_VV]
GLA_IN = 2 * GLA_QK + 2 * GLA_VV + 2 * GLA_GATE_RANK

MLA_HEADS = 16
MLA_NOPE = 128
MLA_ROPE = 64
MLA_V = 128
MLA_Q_RANK = 512
MLA_KV_RANK = 256
MLA_IN = MLA_Q_RANK + MLA_KV_RANK + MLA_ROPE
MLA_SCALE = (MLA_NOPE + MLA_ROPE) ** -0.5
Q_BLOCK = 128
ROPE_BASE = 10000.0

kernel_name = 'hybrid_gla_mla_prefix_diffusion_step'


def rms_norm(x, g):
    xf = x.astype(jnp.float32)
    y = xf * lax.rsqrt(jnp.mean(xf * xf, axis=-1, keepdims=True) + EPS)
    return (y * g.astype(jnp.float32)).astype(x.dtype)


def swiglu(h, w_in, w_out):
    g, u = jnp.split(h @ w_in, 2, axis=-1)
    return (jax.nn.silu(g) * u) @ w_out


def modulation(cond, w_mod, b_mod):
    m = jax.nn.silu(cond) @ w_mod + b_mod
    return jnp.split(m[..., None, :], N_MOD, axis=-1)


def axial_rope_tables(n_tokens):
    rows = n_tokens // GRID_W
    row = jnp.repeat(jnp.arange(rows), GRID_W).astype(jnp.float32)
    col = jnp.tile(jnp.arange(GRID_W), rows).astype(jnp.float32)
    n_pairs = MLA_ROPE // 4
    inv = ROPE_BASE ** (-jnp.arange(n_pairs, dtype=jnp.float32) / n_pairs)
    ang = jnp.stack([row[:, None] * inv, col[:, None] * inv], axis=1)
    return jnp.cos(ang), jnp.sin(ang)


def apply_axial_rope(x, cos, sin):
    xs = x.reshape(x.shape[:-1] + (2, 2, MLA_ROPE // 4)).astype(jnp.float32)
    x1, x2 = xs[..., 0, :], xs[..., 1, :]
    out = jnp.stack([x1 * cos - x2 * sin, x2 * cos + x1 * sin], axis=-2)
    return out.reshape(x.shape).astype(x.dtype)


def gla_scan(q, k, v, log_a, h0):
    bsz, t = q.shape[0], q.shape[1]
    n = t // GLA_CHUNK

    def chunks(a):
        return jnp.moveaxis(a.reshape((bsz, n, GLA_CHUNK) + a.shape[2:]), 1, 0)

    lower = jnp.tril(jnp.ones((GLA_CHUNK, GLA_CHUNK), bool))[None, :, :, None, None]

    def step(h, inp):
        qc, kc, vc, gc = inp
        b = jnp.cumsum(gc, axis=1)
        diff = jnp.where(lower, b[:, :, None] - b[:, None, :], -jnp.inf)
        attn = jnp.einsum('bijhd,bjhd->bhij', qc[:, :, None] * jnp.exp(diff), kc)
        o = (jnp.einsum('bhij,bjhv->bihv', attn, vc)
             + jnp.einsum('bihd,bhdv->bihv', qc * jnp.exp(b), h))
        b_last = b[:, -1]
        h = (jnp.exp(b_last)[..., None] * h
             + jnp.einsum('bjhd,bjhv->bhdv', kc * jnp.exp(b_last[:, None] - b), vc))
        return h, o

    h_final, o = lax.scan(step, h0, (chunks(q), chunks(k), chunks(v), chunks(log_a)))
    return jnp.moveaxis(o, 0, 1).reshape(v.shape), h_final


def gla_mixer(h, w_in, w_gate, b_gate, g_out, w_out, state0):
    bsz, t = h.shape[0], h.shape[1]
    f32 = jnp.float32
    q, k, v, r, z = jnp.split(h @ w_in, GLA_SPLITS, axis=-1)
    q = q.reshape(bsz, t, GLA_HEADS, GLA_DK).astype(f32) * (GLA_DK ** -0.5)
    k = k.reshape(bsz, t, GLA_HEADS, GLA_DK).astype(f32)
    v = v.reshape(bsz, t, GLA_HEADS, GLA_DV).astype(f32)
    z = z.reshape(bsz, t, 2, GLA_GATE_RANK)
    logit = jnp.einsum('btdr,drk->btdk', z, w_gate) + b_gate
    log_a = (jax.nn.log_sigmoid(logit.astype(f32)) / GLA_TAU).reshape(bsz, t, 2, GLA_HEADS, GLA_DK)
    o_f, s_f = gla_scan(q, k, v, log_a[:, :, 0], state0[:, 0])
    o_b, s_b = gla_scan(q[:, ::-1], k[:, ::-1], v[:, ::-1], log_a[:, ::-1, 1], state0[:, 1])
    o = rms_norm(o_f + o_b[:, ::-1], g_out.reshape(GLA_HEADS, GLA_DV))
    o = o.reshape(bsz, t, GLA_VV).astype(h.dtype) * jax.nn.silu(r)
    return o @ w_out, jnp.stack([s_f, s_b], axis=1)


def mla_project(h, w_in, g_q, g_kv):
    cq, ckv, kr = jnp.split(h @ w_in, [MLA_Q_RANK, MLA_Q_RANK + MLA_KV_RANK], axis=-1)
    return rms_norm(cq, g_q), rms_norm(ckv, g_kv), kr


def mla_heads(cq, ckv_all, w_uq, w_ukv):
    bsz, tq = cq.shape[0], cq.shape[1]
    tk = ckv_all.shape[1]
    q = (cq @ w_uq).reshape(bsz, tq, MLA_HEADS, MLA_NOPE + MLA_ROPE)
    kv = (ckv_all @ w_ukv).reshape(bsz, tk, MLA_HEADS, MLA_NOPE + MLA_V)
    return q[..., :MLA_NOPE], q[..., MLA_NOPE:], kv[..., :MLA_NOPE], kv[..., MLA_NOPE:]


def mla_attention(q_nope, q_rope, k_nope, k_rope, v):
    bsz, tq = q_nope.shape[0], q_nope.shape[1]
    nb = tq // Q_BLOCK

    def blocks(a):
        return jnp.moveaxis(a.reshape((bsz, nb, Q_BLOCK) + a.shape[2:]), 1, 0)

    def one_block(qs):
        qn, qr = qs
        s = jnp.einsum('bqhd,bkhd->bhqk', qn, k_nope) + jnp.einsum('bqhr,bkr->bhqk', qr, k_rope)
        p = jax.nn.softmax(s.astype(jnp.float32) * MLA_SCALE, axis=-1).astype(v.dtype)
        return jnp.einsum('bhqk,bkhv->bqhv', p, v)

    o = lax.map(one_block, (blocks(q_nope), blocks(q_rope)))
    return jnp.moveaxis(o, 0, 1).reshape(bsz, tq, MLA_HEADS * MLA_V)


def mla_context(h, w_in, g_q, g_kv, w_uq, w_ukv, w_out):
    cq, ckv, kr = mla_project(h, w_in, g_q, g_kv)
    qn, qr, kn, v = mla_heads(cq, ckv, w_uq, w_ukv)
    return mla_attention(qn, qr, kn, kr, v) @ w_out, (ckv, kr)


def mla_latent(h, ckv_ctx, kr_ctx, w_in, g_q, g_kv, w_uq, w_ukv, w_out):
    cq, ckv, kr = mla_project(h, w_in, g_q, g_kv)
    cos, sin = axial_rope_tables(h.shape[1])
    ckv_all = jnp.concatenate([ckv_ctx.astype(ckv.dtype), ckv], axis=1)
    kr_all = jnp.concatenate([kr_ctx.astype(kr.dtype), apply_axial_rope(kr, cos, sin)], axis=1)
    qn, qr, kn, v = mla_heads(cq, ckv_all, w_uq, w_ukv)
    qr = apply_axial_rope(qr, cos[:, None], sin[:, None])
    return mla_attention(qn, qr, kn, kr_all, v) @ w_out


def run_layer(x, mods, g_norm, w_ffn_in, w_ffn_out, mixer):
    def sub(x, i, fn, weight):
        shift, scale, gate = mods[3 * i], mods[3 * i + 1], mods[3 * i + 2]
        h = rms_norm(x, g_norm[i, 0]) * (1.0 + scale) + shift
        y, aux = fn(h)
        return x + weight * gate * rms_norm(y, g_norm[i, 1]), aux

    x, _ = sub(x, 0, lambda h: (swiglu(h, w_ffn_in[0], w_ffn_out[0]), None), MACARON_W)
    x, aux = sub(x, 1, mixer, 1.0)
    x, _ = sub(x, 2, lambda h: (swiglu(h, w_ffn_in[1], w_ffn_out[1]), None), MACARON_W)
    return x, aux


def setup_inputs(seed: int = 0) -> dict:
    key = jax.random.key(seed)
    ks = jax.random.split(key, 32)
    f32 = jnp.float32

    def nrm(k, shape, fan_in, gain=1.0):
        return jax.random.normal(k, shape, f32) * (gain * fan_in ** -0.5)

    def gains(k, shape):
        return 1.0 + 0.05 * jax.random.normal(k, shape, f32)

    D = D_MODEL
    return {
        'x_prompt': jax.random.normal(ks[0], (BATCH, SEQ, D), f32),
        'x_sample': jax.random.normal(ks[1], (DEC_BATCH, DEC_SEQ, D), f32),
        'state_gla': jax.random.normal(ks[2], (DEC_BATCH, N_GLA_LAYERS, 2, GLA_HEADS, GLA_DK, GLA_DV), f32),
        'cache_mla_ckv': jax.random.normal(ks[3], (DEC_BATCH, N_MLA_LAYERS, PAST_LEN, MLA_KV_RANK), f32),
        'cache_mla_krope': jax.random.normal(ks[4], (DEC_BATCH, N_MLA_LAYERS, PAST_LEN, MLA_ROPE), f32),
        'c': jax.random.normal(ks[5], (DEC_BATCH, D), f32),
        'c_ctx': jax.random.normal(ks[6], (D,), f32),
        'w_mod': nrm(ks[7], (DEPTH, D, N_MOD * D), D, 0.5),
        'b_mod': 0.02 * jax.random.normal(ks[8], (DEPTH, N_MOD * D), f32),
        'g_norm': gains(ks[9], (DEPTH, 3, 2, D)),
        'w_ffn_in': nrm(ks[10], (DEPTH, 2, D, 2 * D_FF), D),
        'w_ffn_out': nrm(ks[11], (DEPTH, 2, D_FF, D), D_FF),
        'gla_w_in': nrm(ks[12], (N_GLA_LAYERS, D, GLA_IN), D),
        'gla_w_gate': nrm(ks[13], (N_GLA_LAYERS, 2, GLA_GATE_RANK, GLA_QK), GLA_GATE_RANK),
        'gla_b_gate': 0.1 * jax.random.normal(ks[14], (N_GLA_LAYERS, 2, GLA_QK), f32),
        'gla_g_out': gains(ks[15], (N_GLA_LAYERS, GLA_VV)),
        'gla_w_out': nrm(ks[16], (N_GLA_LAYERS, GLA_VV, D), GLA_VV),
        'mla_w_in': nrm(ks[17], (N_MLA_LAYERS, D, MLA_IN), D),
        'mla_g_q': gains(ks[18], (N_MLA_LAYERS, MLA_Q_RANK)),
        'mla_g_kv': gains(ks[19], (N_MLA_LAYERS, MLA_KV_RANK)),
        'mla_w_uq': nrm(ks[20], (N_MLA_LAYERS, MLA_Q_RANK, MLA_HEADS * (MLA_NOPE + MLA_ROPE)), MLA_Q_RANK),
        'mla_w_ukv': nrm(ks[21], (N_MLA_LAYERS, MLA_KV_RANK, MLA_HEADS * (MLA_NOPE + MLA_V)), MLA_KV_RANK),
        'mla_w_out': nrm(ks[22], (N_MLA_LAYERS, MLA_HEADS * MLA_V, D), MLA_HEADS * MLA_V),
    }


def reference(x_prompt, x_sample, state_gla, cache_mla_ckv, cache_mla_krope, c, c_ctx,
              w_mod, b_mod, g_norm, w_ffn_in, w_ffn_out,
              gla_w_in, gla_w_gate, gla_b_gate, gla_g_out, gla_w_out,
              mla_w_in, mla_g_q, mla_g_kv, mla_w_uq, mla_w_ukv, mla_w_out):
    f32 = jnp.float32
    yp, ys = x_prompt, x_sample
    gla_states, mla_ckvs, mla_krs = [], [], []
    for l in range(DEPTH):
        mods_ctx = modulation(c_ctx, w_mod[l], b_mod[l])
        mods_lat = modulation(c, w_mod[l], b_mod[l])
        j = l // N_MIXERS
        if l % N_MIXERS == 0:
            p = (gla_w_in[j], gla_w_gate[j], gla_b_gate[j], gla_g_out[j], gla_w_out[j])
            zeros = jnp.zeros((yp.shape[0], 2, GLA_HEADS, GLA_DK, GLA_DV), f32)
            yp, st = run_layer(yp, mods_ctx, g_norm[l], w_ffn_in[l], w_ffn_out[l],
                               lambda h: gla_mixer(h, *p, zeros))
            gla_states.append(st)
            s0 = state_gla[:, j].astype(f32)
            ys, _ = run_layer(ys, mods_lat, g_norm[l], w_ffn_in[l], w_ffn_out[l],
                              lambda h: (gla_mixer(h, *p, s0)[0], None))
        else:
            p = (mla_w_in[j], mla_g_q[j], mla_g_kv[j], mla_w_uq[j], mla_w_ukv[j], mla_w_out[j])
            yp, (ckv, kr) = run_layer(yp, mods_ctx, g_norm[l], w_ffn_in[l], w_ffn_out[l],
                                      lambda h: mla_context(h, *p))
            mla_ckvs.append(ckv)
            mla_krs.append(kr)
            ckv_ctx, kr_ctx = cache_mla_ckv[:, j], cache_mla_krope[:, j]
            ys, _ = run_layer(ys, mods_lat, g_norm[l], w_ffn_in[l], w_ffn_out[l],
                              lambda h: (mla_latent(h, ckv_ctx, kr_ctx, *p), None))
    new_state_gla = jnp.stack(gla_states, axis=1).astype(x_prompt.dtype)
    new_cache_mla_ckv = jnp.stack(mla_ckvs, axis=1)
    new_cache_mla_krope = jnp.stack(mla_krs, axis=1)
    return (yp, ys, new_state_gla, new_cache_mla_ckv, new_cache_mla_krope)
```

```cpp
#include <hip/hip_runtime.h>
#include <hip/hip_cooperative_groups.h>
#include <cstdint>
#include <cstdio>
namespace cg = cooperative_groups;
#ifndef PROBE
#define PROBE 0
#endif

typedef unsigned short bf16_t;
typedef short bf16x8 __attribute__((ext_vector_type(8)));
typedef float f32x4 __attribute__((ext_vector_type(4)));
typedef unsigned u32x4 __attribute__((ext_vector_type(4)));
typedef unsigned u32x2 __attribute__((ext_vector_type(2)));
#define LAS __attribute__((address_space(3)))

constexpr int NT = 512;
constexpr int D = 1024, T_CTX = 4096, T_LAT = 16384, T = 20480, DFF = 2816;
constexpr float EPS = 1e-6f;
constexpr int KV_ROWS = 21504;
constexpr size_t OUT_STATE = 20971520, OUT_CKV = 25165824, OUT_KR = 26214400;
constexpr int LDS_BYTES = 131072 + 16;

constexpr size_t OFF_MODS = 0;
constexpr size_t SZ_MODS = 2 * 5 * 9216 * 4;
constexpr size_t OFF_BAR = OFF_MODS + SZ_MODS;
constexpr size_t SZ_BAR = 16384;
constexpr size_t OFF_ROPE = OFF_BAR + SZ_BAR;
constexpr size_t OFF_W16 = OFF_ROPE + 8192;
constexpr size_t W_FFN_IN = (size_t)5632 * 1024 * 2, W_FFN_OUT = (size_t)1024 * 2816 * 2;
constexpr size_t WO_FI0 = 0, WO_FO0 = WO_FI0 + W_FFN_IN, WO_FI1 = WO_FO0 + W_FFN_OUT, WO_FO1 = WO_FI1 + W_FFN_IN, WO_MIX = WO_FO1 + W_FFN_OUT;
constexpr size_t WO_GLA_IN = WO_MIX, WO_GLA_OUT = WO_GLA_IN + (size_t)3328 * 1024 * 2;
constexpr size_t WO_MLA_IN = WO_MIX, WO_MLA_UQ = WO_MLA_IN + (size_t)1024 * 1024 * 2, WO_MLA_UKV = WO_MLA_UQ + (size_t)3072 * 512 * 2,
                 WO_MLA_OUT = WO_MLA_UKV + (size_t)4096 * 256 * 2;
constexpr size_t SZ_W16 = WO_MLA_OUT + (size_t)1024 * 2048 * 2;
constexpr size_t OFF_H = OFF_W16 + SZ_W16;
constexpr size_t SZ_H = (size_t)T * 1024 * 2;
constexpr size_t OFF_Y = OFF_H + SZ_H;
constexpr size_t SZ_Y = (size_t)T * 1024 * 4;
constexpr size_t OFF_BIG = OFF_Y + SZ_Y;
constexpr size_t OFF_ACT = OFF_BIG;
constexpr size_t OFF_QK = OFF_BIG;
constexpr size_t OFF_GVT = OFF_QK + SZ_H;
constexpr size_t OFF_R = OFF_GVT + SZ_H;
constexpr size_t OFF_KF = OFF_R + SZ_H;
constexpr size_t OFF_AF = OFF_KF + SZ_H;
constexpr size_t OFF_Z = OFF_AF + (size_t)2560 * 4096 * 2;
constexpr size_t OFF_DEC = OFF_Z + (size_t)T * 32 * 4;
constexpr size_t END_GLA = OFF_DEC + (size_t)2560 * 128 * 4;
constexpr size_t OFF_QF = OFF_H;
constexpr size_t OFF_OF = OFF_Y;
constexpr size_t OFF_PM = OFF_Y;
constexpr size_t OFF_CQN = OFF_H;
constexpr size_t OFF_CKV = OFF_CQN + (size_t)T * 512 * 2;
constexpr size_t OFF_KR = OFF_CKV + (size_t)KV_ROWS * 256 * 2;
constexpr size_t OFF_Q = OFF_BIG;
constexpr size_t OFF_KN = OFF_Q + (size_t)12288 * 3072 * 2;
constexpr size_t OFF_MVT = OFF_KN + (size_t)12800 * 2048 * 2;
constexpr size_t END_MLA = OFF_MVT + (size_t)12800 * 2048 * 2;
constexpr size_t WS_NEED = (END_GLA > END_MLA ? END_GLA : END_MLA);
static_assert(OFF_KR + (size_t)KV_ROWS * 64 * 2 <= OFF_Y, "mla small buffers overflow H region");
static_assert(OFF_ACT + (size_t)T * DFF * 2 <= WS_NEED, "act");
static_assert(WS_NEED <= 369098752, "workspace");

struct Params {
    const float *x_prompt, *x_sample, *state_gla, *cache_ckv, *cache_kr, *c, *c_ctx;
    const float *w_mod, *b_mod, *g_norm, *w_ffn_in, *w_ffn_out;
    const float *gla_w_in, *gla_w_gate, *gla_b_gate, *gla_g_out, *gla_w_out;
    const float *mla_w_in, *mla_g_q, *mla_g_kv, *mla_w_uq, *mla_w_ukv, *mla_w_out;
    float* out;
    char* ws;
};

typedef const __attribute__((address_space(4))) Params& PRef;

typedef float f32x2 __attribute__((ext_vector_type(2)));
typedef __bf16 bf16x2v __attribute__((ext_vector_type(2)));
__device__ __forceinline__ unsigned pk2(float a, float b) { f32x2 v = {a, b}; return __builtin_bit_cast(unsigned, __builtin_convertvector(v, bf16x2v)); }
__device__ __forceinline__ bf16_t f2bf(float a) { return (bf16_t)(pk2(a, 0.f) & 0xffffu); }
__device__ __forceinline__ float bf2f(bf16_t v) { return __uint_as_float(((unsigned)v) << 16); }
__device__ __forceinline__ float bflo(unsigned v) { return __uint_as_float(v << 16); }
__device__ __forceinline__ float bfhi(unsigned v) { return __uint_as_float(v & 0xffff0000u); }
__device__ __forceinline__ float wave_sum(float v) {
#pragma unroll
    for (int o = 32; o; o >>= 1) v += __shfl_xor(v, o);
    return v;
}
__device__ __forceinline__ float silu_f(float x) { return x * __builtin_amdgcn_rcpf(1.f + __builtin_amdgcn_exp2f(-1.4426950408889634f * x)); }
__device__ __forceinline__ f32x4 mfma16(bf16x8 a, bf16x8 b, f32x4 c) { return __builtin_amdgcn_mfma_f32_16x16x32_bf16(a, b, c, 0, 0, 0); }
__device__ __forceinline__ bf16x8 as_bf8(u32x4 v) { return __builtin_bit_cast(bf16x8, v); }
__device__ __forceinline__ int cond_of(int t) { return t < T_CTX ? 0 : 1 + ((t - T_CTX) >> 12); }
__device__ __forceinline__ int otid(int wv) { unsigned z = 0; asm volatile("" : "+v"(z)); int t = wv * 64 + (int)__builtin_amdgcn_mbcnt_hi(~0u, __builtin_amdgcn_mbcnt_lo(~0u, z)); asm volatile("" : "+v"(t)); return t; }
__device__ __forceinline__ u32x2 pk4(f32x4 v) { u32x2 o; o.x = pk2(v[0], v[1]); o.y = pk2(v[2], v[3]); return o; }

__device__ void mods_phase(PRef p, int layer, char* lds, int wv) {
    const int TIDX = otid(wv);
    const int tid = TIDX & 255, hf = TIDX >> 8;
    float* sc = (float*)lds + hf * 160;
    float* mods = (float*)(p.ws + OFF_MODS);
    for (int it = blockIdx.x; it < 9 * 16; it += gridDim.x) {
        const int l = layer, rem = it, nt = rem / 16, ks = (rem % 16) * 2 + hf;
        const int k0 = ks * 32;
        __syncthreads();
        if (tid < 160) {
            const int ci = tid >> 5, kk = tid & 31;
            const float cv = ci == 0 ? p.c_ctx[k0 + kk] : p.c[(ci - 1) * 1024 + k0 + kk];
            sc[tid] = silu_f(cv);
        }
        __syncthreads();
        const int n = nt * 1024 + tid * 4;
        f32x4 acc[5];
#pragma unroll
        for (int ci = 0; ci < 5; ++ci) acc[ci] = (f32x4){0.f, 0.f, 0.f, 0.f};
        const float* wp = p.w_mod + ((size_t)l * 1024 + k0) * 9216 + n;
#pragma unroll 8
        for (int kk = 0; kk < 32; ++kk) {
            const f32x4 w = *(const f32x4*)(wp + (size_t)kk * 9216);
#pragma unroll
            for (int ci = 0; ci < 5; ++ci) acc[ci] += w * sc[ci * 32 + kk];
        }
        if (ks == 0) {
            const f32x4 b = *(const f32x4*)(p.b_mod + l * 9216 + n);
#pragma unroll
            for (int ci = 0; ci < 5; ++ci) acc[ci] += b;
        }
#pragma unroll
        for (int ci = 0; ci < 5; ++ci)
#pragma unroll
            for (int j = 0; j < 4; ++j) atomicAdd(mods + ((size_t)l * 5 + ci) * 9216 + n + j, acc[ci][j]);
    }
    if (blockIdx.x == gridDim.x - 1 && layer == 0) {
        float* rt = (float*)(p.ws + OFF_ROPE);
        for (int i = TIDX; i < 1024; i += NT) {
            const int pos = i >> 4, f = i & 15;
            const float inv = exp2f(-(float)f * (13.287712379549449f / 16.f));
            const float x = (float)pos * inv;
            const float k = rintf(x * 0.15915494309189535f);
            float r = fmaf(-k, 6.28318548202514648f, x);
            r = fmaf(-k, -1.7484555e-7f, r);
            rt[i * 2] = __cosf(r);
            rt[i * 2 + 1] = __sinf(r);
        }
    }
}

#define CONV_BAR() do { asm volatile("s_waitcnt lgkmcnt(0)" ::: "memory"); __builtin_amdgcn_s_barrier(); asm volatile("" ::: "memory"); } while (0)
__device__ void conv_matrix_tile(const float* __restrict__ src, bf16_t* __restrict__ dst, int K, int N, int perm, int kt, int nt, bool valid, bf16_t* tile, int tid) {
    CONV_BAR();
    if (valid) {
        const int c4 = tid & 15, r0 = tid >> 4;
#pragma unroll
        for (int j = 0; j < 4; ++j) {
            const int r = r0 + 16 * j;
            const int n = nt * 64 + c4 * 4;
            f32x4 v = (f32x4){0.f, 0.f, 0.f, 0.f};
            if (n < N) v = *(const f32x4*)(src + (size_t)(kt * 64 + r) * N + n);
#pragma unroll
            for (int e = 0; e < 4; ++e) tile[(c4 * 4 + e) * 72 + r] = f2bf(v[e]);
        }
    }
    CONV_BAR();
    if (valid) {
        const int c = tid >> 2, kc = tid & 3;
        const int n = nt * 64 + c;
        int np = n;
        if (perm == 1) np = n < DFF ? ((n >> 4) * 32 + (n & 15)) : (((n - DFF) >> 4) * 32 + 16 + ((n - DFF) & 15));
        else if (perm == 2) np = ((n & 255) < 128) ? ((n >> 8) * 128 + (n & 127)) : (2048 + (n >> 8) * 128 + (n & 127));
        const u32x4 v0 = *(const u32x4*)(tile + c * 72 + kc * 16);
        const u32x4 v1 = *(const u32x4*)(tile + c * 72 + kc * 16 + 8);
        bf16_t* d = dst + (size_t)np * K + kt * 64 + kc * 16;
        *(u32x4*)d = v0;
        *(u32x4*)(d + 8) = v1;
    }
}

__device__ void conv_phase(PRef p, int layer, int mask, int vfirst, int vcount, char* lds, int wv) {
    const int TIDX = otid(wv);
    char* w16 = p.ws + OFF_W16;
    const int tid = TIDX & 255, hf = TIDX >> 8;
    bf16_t* tile = (bf16_t*)(lds + hf * 9216);
    if ((int)blockIdx.x < vfirst || (int)blockIdx.x >= vfirst + vcount) return;
    const int vc = blockIdx.x - vfirst, vG = ((int)gridDim.x - vfirst) < vcount ? ((int)gridDim.x - vfirst) : vcount;
    for (int m = 0; m < 8; ++m) {
        if (!((mask >> m) & 1)) continue;
        const float* src; bf16_t* dst; int K, N, Np, perm = 0;
        if (m == 0)      { src = p.w_ffn_in + (size_t)(layer * 2 + 0) * 1024 * 5632; dst = (bf16_t*)(w16 + WO_FI0); K = 1024; N = 5632; Np = 5632; perm = 1; }
        else if (m == 1) { src = p.w_ffn_out + (size_t)(layer * 2 + 0) * 2816 * 1024; dst = (bf16_t*)(w16 + WO_FO0); K = 2816; N = 1024; Np = 1024; }
        else if (m == 2) { src = p.w_ffn_in + (size_t)(layer * 2 + 1) * 1024 * 5632; dst = (bf16_t*)(w16 + WO_FI1); K = 1024; N = 5632; Np = 5632; perm = 1; }
        else if (m == 3) { src = p.w_ffn_out + (size_t)(layer * 2 + 1) * 2816 * 1024; dst = (bf16_t*)(w16 + WO_FO1); K = 2816; N = 1024; Np = 1024; }
        else if (layer == 0) {
            if (m == 4)      { src = p.gla_w_in; dst = (bf16_t*)(w16 + WO_GLA_IN); K = 1024; N = 3104; Np = 3328; }
            else if (m == 5) { src = p.gla_w_out; dst = (bf16_t*)(w16 + WO_GLA_OUT); K = 1024; N = 1024; Np = 1024; }
            else break;
        } else {
            if (m == 4)      { src = p.mla_w_in; dst = (bf16_t*)(w16 + WO_MLA_IN); K = 1024; N = 832; Np = 1024; }
            else if (m == 5) { src = p.mla_w_uq; dst = (bf16_t*)(w16 + WO_MLA_UQ); K = 512; N = 3072; Np = 3072; }
            else if (m == 6) { src = p.mla_w_ukv; dst = (bf16_t*)(w16 + WO_MLA_UKV); K = 256; N = 4096; Np = 4096; perm = 2; }
            else             { src = p.mla_w_out; dst = (bf16_t*)(w16 + WO_MLA_OUT); K = 2048; N = 1024; Np = 1024; }
        }
        const int nkt = K / 64, nnt = Np / 64, ntiles = nkt * nnt;
        for (int t2 = vc; t2 * 2 < ntiles; t2 += vG) {
            const int t = t2 * 2 + hf;
            conv_matrix_tile(src, dst, K, N, perm, t / nnt, t % nnt, t < ntiles, tile, tid);
        }
    }
}

__device__ void row_phase(PRef p, int lprev, int iprev, float wprev, int lnext, int inext, bool first, int wv, bool dry) {
    const int TIDX = otid(wv);
    const int lane = TIDX & 63, w = TIDX >> 6;
    float* X = p.out;
    const bf16_t* Y = (const bf16_t*)(p.ws + OFF_Y);
    bf16_t* H = (bf16_t*)(p.ws + OFF_H);
    const float* mods = (const float*)(p.ws + OFF_MODS);
    for (int it = blockIdx.x; it < T / 40; it += gridDim.x) {
#pragma unroll
        for (int rr = 0; rr < 5; ++rr) {
            const int t = it * 40 + w * 5 + rr;
            const int ci = cond_of(t);
            const float* xs = first ? (t < T_CTX ? p.x_prompt + (size_t)t * D : p.x_sample + (size_t)(t - T_CTX) * D) : X + (size_t)t * D;
            f32x4 x[4];
#pragma unroll
            for (int j = 0; j < 4; ++j) x[j] = *(const f32x4*)(xs + j * 256 + lane * 4);
            if (iprev >= 0) {
                f32x4 y[4];
                float ss = 0.f;
#pragma unroll
                for (int j = 0; j < 4; ++j) { const u32x2 yb = *(const u32x2*)(Y + (size_t)t * D + j * 256 + lane * 4); y[j] = (f32x4){bflo(yb.x), bfhi(yb.x), bflo(yb.y), bfhi(yb.y)}; ss += y[j][0] * y[j][0] + y[j][1] * y[j][1] + y[j][2] * y[j][2] + y[j][3] * y[j][3]; }
                ss = wave_sum(ss);
                const float rs = rsqrtf(ss * (1.f / 1024.f) + EPS) * wprev;
                const float* gate = mods + ((size_t)lprev * 5 + ci) * 9216 + (3 * iprev + 2) * 1024;
                const float* gp = p.g_norm + ((size_t)(lprev * 3 + iprev) * 2 + 1) * 1024;
#pragma unroll
                for (int j = 0; j < 4; ++j) {
                    const f32x4 g = *(const f32x4*)(gate + j * 256 + lane * 4), gg = *(const f32x4*)(gp + j * 256 + lane * 4);
                    x[j] += g * (y[j] * gg) * rs;
                }
            }
            if (iprev >= 0 && !(dry && p.out != nullptr)) {
#pragma unroll
                for (int j = 0; j < 4; ++j) *(f32x4*)(X + (size_t)t * D + j * 256 + lane * 4) = x[j];
            }
            if (inext >= 0) {
                float ss = 0.f;
#pragma unroll
                for (int j = 0; j < 4; ++j) ss += x[j][0] * x[j][0] + x[j][1] * x[j][1] + x[j][2] * x[j][2] + x[j][3] * x[j][3];
                ss = wave_sum(ss);
                const float rs = rsqrtf(ss * (1.f / 1024.f) + EPS);
                const float* mb = mods + ((size_t)lnext * 5 + ci) * 9216 + (3 * inext) * 1024;
                const float* gp = p.g_norm + ((size_t)(lnext * 3 + inext) * 2 + 0) * 1024;
#pragma unroll
                for (int j = 0; j < 4; ++j) {
                    const int e = j * 256 + lane * 4;
                    const f32x4 sh = *(const f32x4*)(mb + e), scl = *(const f32x4*)(mb + 1024 + e), gg = *(const f32x4*)(gp + e);
                    const f32x4 h = (x[j] * rs) * gg * (scl + 1.f) + sh;
                    if (!(dry && p.out != nullptr)) *(u32x2*)(H + (size_t)t * D + e) = pk4(h);
                }
            }
        }
    }
}

namespace pg8 {
constexpr int BK = 64, HALF = 128, HTB = HALF * BK * 2;
__device__ __forceinline__ int lds_byte(int r, int c) { const int st = (r >> 4) * 2 + (c >> 5), rr = r & 15, cc = c & 31, ob = rr * 64 + cc * 2; return st * 1024 + (ob ^ (((ob >> 9) & 1) << 5)); }
__device__ __forceinline__ void stage_rc(int b, int& R, int& C) { const int st = b / 1024, sb = b % 1024, swz = sb ^ (((sb >> 9) & 1) << 5); R = (st >> 1) * 16 + swz / 64; C = (st & 1) * 32 + (swz % 64) / 2; }
struct Unit { const char* a; const char* b; int pm, pn, kind; };
__device__ __forceinline__ void tile_map(int wgid, int nM, int nN, int& pm, int& pn) {
    const int nwg = nM * nN;
    { const int q = nwg / 8, r = nwg % 8, xcd = wgid % 8, off = wgid / 8; wgid = (xcd < r ? xcd * (q + 1) : r * (q + 1) + (xcd - r) * q) + off; }
    const int nig = 8 * nN, gid = wgid / nig, fm = gid * 8, gsz = (nM - fm) < 8 ? (nM - fm) : 8;
    pm = fm + ((wgid % nig) % gsz); pn = (wgid % nig) / gsz;
}

template <int APAIR, class Epi, class Sched>
__device__ __forceinline__ void gemm_phase(LAS unsigned char* lds, int K, int lda, const Sched& S, const Epi& E, int wv) {
    const int TIDX = otid(wv);
    const int tid = TIDX, wid = __builtin_amdgcn_readfirstlane(tid >> 6), lane = tid & 63, wr = wid >> 2, wc = wid & 3, fr = lane & 15, fq = lane >> 4;
    const int nt = K / BK;
    unsigned voffA[2], voffB[2];
#pragma unroll
    for (int i = 0; i < 2; ++i) { int R, C; stage_rc(tid * 16 + i * 8192, R, C); voffA[i] = (unsigned)(R * lda + C) * 2u; voffB[i] = (unsigned)(R * K + C) * 2u; }
    const size_t kstep = (size_t)(BK * 2);
    const size_t hstepA = (size_t)HALF * lda * 2, hstepB = (size_t)HALF * K * 2;
    const unsigned ldsw = (unsigned)wid * 1024u;
    const int aoff = lds_byte(wr * 64 + fr, fq * 8), boff = lds_byte(wc * 32 + fr, fq * 8);
#define PG8_SA(b, h) (((b) * 2 + (h)) * HTB)
#define PG8_SB(b, h) ((4 + (b) * 2 + (h)) * HTB)
#define PG8_STAGE(bufoff, gbase, voff) do { _Pragma("unroll") for (int _i = 0; _i < 2; ++_i) \
        __builtin_amdgcn_global_load_lds((const unsigned*)((const char*)(gbase) + (voff)[_i]), (LAS unsigned*)(lds + (bufoff) + ldsw + _i * 8192), 16, 0, 0); } while (0)
#define PG8_LDA(dst, b, h) do { _Pragma("unroll") for (int m = 0; m < 4; ++m) _Pragma("unroll") for (int k = 0; k < 2; ++k) dst[m][k] = *(const LAS bf16x8*)(lds + PG8_SA(b, h) + aoff + m * 2048 + k * 1024); } while (0)
#define PG8_LDB(dst, b, h) do { _Pragma("unroll") for (int n = 0; n < 2; ++n) _Pragma("unroll") for (int k = 0; k < 2; ++k) dst[n][k] = *(const LAS bf16x8*)(lds + PG8_SB(b, h) + boff + n * 2048 + k * 1024); } while (0)
#define PG8_MMA(ai, bj, At, Bt) do { __builtin_amdgcn_s_setprio(1); _Pragma("unroll") for (int m = 0; m < 4; ++m) _Pragma("unroll") for (int n = 0; n < 2; ++n) _Pragma("unroll") for (int k = 0; k < 2; ++k) \
        acc[ai][bj][m][n] = __builtin_amdgcn_mfma_f32_16x16x32_bf16(Bt[n][k], At[m][k], acc[ai][bj][m][n], 0, 0, 0); __builtin_amdgcn_s_setprio(0); } while (0)
#define PG8_WAIT_V(n) asm volatile("s_waitcnt vmcnt(" #n ")" ::: "memory")
#define PG8_WAIT_L(n) asm volatile("s_waitcnt lgkmcnt(" #n ")" ::: "memory")
#define PG8_BAR __builtin_amdgcn_s_barrier()
#define PG8_SCHED __builtin_amdgcn_sched_barrier(0)
    Unit cur, nxt; int ui = 0;
    if (!S.next(0, cur)) return;
    f32x4 acc[2][2][4][2];
#pragma unroll
    for (int a = 0; a < 2; ++a)
#pragma unroll
        for (int b = 0; b < 2; ++b)
#pragma unroll
            for (int m = 0; m < 4; ++m)
#pragma unroll
                for (int n = 0; n < 2; ++n) acc[a][b][m][n] = (f32x4){0.f, 0.f, 0.f, 0.f};
    bf16x8 At[4][2], B0[2][2], B1[2][2];
    const char* cA = cur.a; const char* cB = cur.b;
    PG8_STAGE(PG8_SB(0, 0), cB, voffB); PG8_STAGE(PG8_SB(0, 1), cB + hstepB, voffB); PG8_STAGE(PG8_SA(0, 0), cA, voffA); PG8_STAGE(PG8_SA(0, 1), cA + hstepA, voffA);
    if (wr == 1) PG8_BAR;
    PG8_WAIT_V(2); PG8_BAR;
    PG8_STAGE(PG8_SB(1, 0), cB + kstep, voffB); PG8_STAGE(PG8_SA(1, 0), cA + kstep, voffA); PG8_STAGE(PG8_SB(1, 1), cB + hstepB + kstep, voffB);
    PG8_WAIT_V(6); PG8_BAR;
    for (;;) {
        const bool has_next = S.next(ui + 1, nxt);
        const char* nA = has_next ? nxt.a : cA; const char* nB = has_next ? nxt.b : cB;
        for (int t = 0; t < nt; t += 2) {
            const bool last = (t == nt - 2);
            const char* a1 = cA + (size_t)(t >> 1) * APAIR + kstep;
            const char* a2 = last ? nA : cA + (size_t)((t >> 1) + 1) * APAIR; const char* b2 = last ? nB : cB + (size_t)(t + 2) * kstep;
            const char* a3 = a2 + kstep; const char* b3 = b2 + kstep;
            PG8_LDB(B0, 0, 0); PG8_LDB(B1, 0, 1); PG8_SCHED; PG8_LDA(At, 0, 0); PG8_STAGE(PG8_SA(1, 1), a1 + hstepA, voffA);
            PG8_WAIT_V(8); PG8_WAIT_L(0); PG8_BAR; PG8_MMA(0, 0, At, B0); PG8_MMA(0, 1, At, B1); PG8_BAR; PG8_SCHED;
            PG8_LDA(At, 0, 1); PG8_STAGE(PG8_SB(0, 0), b2, voffB); PG8_STAGE(PG8_SB(0, 1), b2 + hstepB, voffB); PG8_STAGE(PG8_SA(0, 0), a2, voffA);
            PG8_WAIT_V(8); PG8_WAIT_L(0); PG8_BAR; PG8_MMA(1, 0, At, B0); PG8_MMA(1, 1, At, B1); PG8_BAR; PG8_SCHED;
            PG8_LDB(B0, 1, 0); PG8_LDB(B1, 1, 1); PG8_SCHED; PG8_LDA(At, 1, 0); PG8_STAGE(PG8_SA(0, 1), a2 + hstepA, voffA);
            PG8_WAIT_V(8); PG8_WAIT_L(0); PG8_BAR; PG8_MMA(0, 0, At, B0); PG8_MMA(0, 1, At, B1); PG8_BAR; PG8_SCHED;
            PG8_LDA(At, 1, 1); PG8_STAGE(PG8_SB(1, 0), b3, voffB); PG8_STAGE(PG8_SB(1, 1), b3 + hstepB, voffB); PG8_STAGE(PG8_SA(1, 0), a3, voffA);
            PG8_WAIT_V(8); PG8_WAIT_L(0); PG8_BAR; PG8_MMA(1, 0, At, B0); PG8_MMA(1, 1, At, B1); PG8_BAR; PG8_SCHED;
        }
        if (wr == 0) PG8_BAR;
        { const int ln2 = otid(0);
          E(acc, cur, wr, wc, ln2 & 15, ln2 >> 4); }
        if (!has_next) break;
#pragma unroll
        for (int a = 0; a < 2; ++a)
#pragma unroll
            for (int b = 0; b < 2; ++b)
#pragma unroll
                for (int m = 0; m < 4; ++m)
#pragma unroll
                    for (int n = 0; n < 2; ++n) acc[a][b][m][n] = (f32x4){0.f, 0.f, 0.f, 0.f};
        cur = nxt; cA = nA; cB = nB; ++ui;
        if (wr == 1) PG8_BAR;
    }
    PG8_WAIT_V(0);
    PG8_BAR;
#undef PG8_SA
#undef PG8_SB
#undef PG8_STAGE
#undef PG8_LDA
#undef PG8_LDB
#undef PG8_MMA
#undef PG8_WAIT_V
#undef PG8_WAIT_L
#undef PG8_BAR
#undef PG8_SCHED
}
}
using pg8::Unit;
typedef f32x4 Acc[2][2][4][2];

struct Sched3 {
    int n0, nM0, nN0, n1, nM1, nN1;
    const char *a0, *b0, *a1, *b1;
    size_t ta, tb;
    int c, G;
    int bskip_from, bskip_by;
    __device__ __forceinline__ bool next(int i, Unit& u) const {
        int L = i * G + c;
        int k, nm, nn; const char* ab; const char* bb;
        if (L < n0) { k = 0; nm = nM0; nn = nN0; ab = a0; bb = b0; }
        else { L -= n0; if (L >= n1) return false; k = 1; nm = nM1; nn = nN1; ab = a1; bb = b1; }
        int pm, pn; pg8::tile_map(L, nm, nn, pm, pn);
        if (k == 0 && pn >= bskip_from) pn += bskip_by;
        u.pm = pm; u.pn = pn; u.kind = k;
        u.a = ab + (size_t)pm * ta; u.b = bb + (size_t)pn * tb;
        return true;
    }
};
__device__ __forceinline__ Sched3 make_sched(int c, int G, size_t ta, size_t tb) {
    Sched3 s; s.n0 = 0; s.nM0 = 1; s.nN0 = 1; s.n1 = 0; s.nM1 = 1; s.nN1 = 1; s.a0 = nullptr; s.b0 = nullptr; s.a1 = nullptr; s.b1 = nullptr;
    s.ta = ta; s.tb = tb; s.c = c; s.G = G; s.bskip_from = 1 << 30; s.bskip_by = 0; return s;
}

struct EpiFfnIn {
    bf16_t* act;
    __device__ __forceinline__ void operator()(Acc& acc, const Unit& u, int wr, int wc, int fr, int fq) const {
#pragma unroll
        for (int ai = 0; ai < 2; ++ai)
#pragma unroll
            for (int m = 0; m < 4; ++m) {
                bf16_t* rp = act + (size_t)(u.pm * 256 + ai * 128 + wr * 64 + m * 16 + fr) * DFF + u.pn * 128 + wc * 16 + fq * 4;
#pragma unroll
                for (int bj = 0; bj < 2; ++bj) {
                    const f32x4 g = acc[ai][bj][m][0], uu = acc[ai][bj][m][1];
                    u32x2 o; o.x = pk2(silu_f(g[0]) * uu[0], silu_f(g[1]) * uu[1]); o.y = pk2(silu_f(g[2]) * uu[2], silu_f(g[3]) * uu[3]);
                    *(u32x2*)(rp + bj * 64) = o;
                }
            }
    }
};
struct EpiF32 {
    float* C; int ldc; int ncols;
    __device__ __forceinline__ void operator()(Acc& acc, const Unit& u, int wr, int wc, int fr, int fq) const {
#pragma unroll
        for (int ai = 0; ai < 2; ++ai)
#pragma unroll
            for (int m = 0; m < 4; ++m) {
                float* rp = C + (size_t)(u.pm * 256 + ai * 128 + wr * 64 + m * 16 + fr) * ldc;
#pragma unroll
                for (int bj = 0; bj < 2; ++bj)
#pragma unroll
                    for (int n = 0; n < 2; ++n) {
                        const int col = u.pn * 256 + bj * 128 + wc * 32 + n * 16 + fq * 4;
                        if (col < ncols) *(f32x4*)(rp + col) = acc[ai][bj][m][n];
                    }
            }
    }
};
struct EpiBf16Y {
    bf16_t* C;
    __device__ __forceinline__ void operator()(Acc& acc, const Unit& u, int wr, int wc, int fr, int fq) const {
#pragma unroll
        for (int ai = 0; ai < 2; ++ai)
#pragma unroll
            for (int m = 0; m < 4; ++m) {
                bf16_t* rp = C + (size_t)(u.pm * 256 + ai * 128 + wr * 64 + m * 16 + fr) * 1024 + u.pn * 256 + wc * 32 + fq * 4;
#pragma unroll
                for (int bj = 0; bj < 2; ++bj)
#pragma unroll
                    for (int n = 0; n < 2; ++n) *(u32x2*)(rp + bj * 128 + n * 16) = pk4(acc[ai][bj][m][n]);
            }
    }
};
struct EpiGlaIn {
    bf16_t* qk; bf16_t* r; float* z; bf16_t* vt;
    __device__ __forceinline__ void operator()(Acc& acc, const Unit& u, int wr, int wc, int fr, int fq) const {
        if (u.kind == 0) {
#pragma unroll
            for (int ai = 0; ai < 2; ++ai)
#pragma unroll
                for (int m = 0; m < 4; ++m) {
                    const size_t row = u.pm * 256 + ai * 128 + wr * 64 + m * 16 + fr;
#pragma unroll
                    for (int bj = 0; bj < 2; ++bj)
#pragma unroll
                        for (int n = 0; n < 2; ++n) {
                            const int col = u.pn * 256 + bj * 128 + wc * 32 + n * 16 + fq * 4;
                            const f32x4 v = acc[ai][bj][m][n];
                            if (col < 1024) *(u32x2*)(qk + row * 1024 + col) = pk4(v);
                            else if (col >= 2048 && col < 3072) *(u32x2*)(r + row * 1024 + (col - 2048)) = pk4(v);
                            else if (col >= 3072 && col < 3104) *(f32x4*)(z + row * 32 + (col - 3072)) = v;
                        }
                }
        } else {
            bf16_t* base = vt + (size_t)(u.pn * 4 + (wc >> 1)) * 65536 + u.pm * 16384 + (wr * 4) * 1024 + (wc & 1) * 512 + (fq * 16 + fr) * 8;
#pragma unroll
            for (int ai = 0; ai < 2; ++ai)
#pragma unroll
                for (int m = 0; m < 4; ++m)
#pragma unroll
                    for (int bj = 0; bj < 2; ++bj)
#pragma unroll
                        for (int n = 0; n < 2; ++n) *(u32x2*)(base + bj * 131072 + (ai * 8 + m) * 1024 + n * 4) = pk4(acc[ai][bj][m][n]);
        }
    }
};
struct EpiMlaQ {
    bf16_t* q; int row0; const float* rope;
    __device__ __forceinline__ void operator()(Acc& acc, const Unit& u, int wr, int wc, int fr, int fq) const {
        const float qs = 0.07216878364870323f * 1.4426950408889634f;
#pragma unroll
        for (int bj = 0; bj < 2; ++bj) {
            const int c0 = u.pn * 256 + bj * 128 + wc * 32;
            const int sec = c0 % 192;
#pragma unroll
            for (int ai = 0; ai < 2; ++ai)
#pragma unroll
                for (int m = 0; m < 4; ++m) {
                    const int lrow = u.pm * 256 + ai * 128 + wr * 64 + m * 16 + fr;
                    const int t = row0 + lrow;
                    f32x4 v0 = acc[ai][bj][m][0], v1 = acc[ai][bj][m][1];
                    if (sec >= 128 && t >= T_CTX) {
                        const int s = (t - T_CTX) & 4095;
                        const int pos = sec == 128 ? (s >> 6) : (s & 63);
#pragma unroll
                        for (int j = 0; j < 4; ++j) {
                            const float cs = rope[(pos * 16 + fq * 4 + j) * 2], sn = rope[(pos * 16 + fq * 4 + j) * 2 + 1];
                            const float a1 = v0[j], a2 = v1[j];
                            v0[j] = a1 * cs - a2 * sn; v1[j] = a2 * cs + a1 * sn;
                        }
                    }
                    bf16_t* rp = q + (size_t)lrow * 3072 + c0 + fq * 4;
                    *(u32x2*)(rp) = pk4(v0 * qs);
                    *(u32x2*)(rp + 16) = pk4(v1 * qs);
                }
        }
    }
};
struct EpiMlaKv {
    bf16_t* kn; bf16_t* vt;
    __device__ __forceinline__ void operator()(Acc& acc, const Unit& u, int wr, int wc, int fr, int fq) const {
        if (u.kind == 0) {
            bf16_t* base = kn + (size_t)(u.pm * 256 + wr * 64 + fr) * 2048 + u.pn * 256 + wc * 32 + fq * 4;
#pragma unroll
            for (int ai = 0; ai < 2; ++ai)
#pragma unroll
                for (int m = 0; m < 4; ++m)
#pragma unroll
                    for (int bj = 0; bj < 2; ++bj)
#pragma unroll
                        for (int n = 0; n < 2; ++n) *(u32x2*)(base + (ai * 128 + m * 16) * 2048 + bj * 128 + n * 16) = pk4(acc[ai][bj][m][n]);
        } else {
            bf16_t* base = vt + (size_t)(u.pn * 4 + (wc >> 1)) * 131072 + (u.pm * 2) * 8192 + (wr * 4) * 1024 + (wc & 1) * 512 + (fq * 16 + fr) * 8;
#pragma unroll
            for (int ai = 0; ai < 2; ++ai)
#pragma unroll
                for (int m = 0; m < 4; ++m)
#pragma unroll
                    for (int bj = 0; bj < 2; ++bj)
#pragma unroll
                        for (int n = 0; n < 2; ++n) *(u32x2*)(base + bj * 262144 + ai * 8192 + m * 1024 + n * 4) = pk4(acc[ai][bj][m][n]);
        }
    }
};

__device__ void ffn_in_phase(PRef p, size_t woff, LAS unsigned char* lds, int wv) {
    Sched3 s = make_sched(blockIdx.x, gridDim.x, (size_t)256 * 1024 * 2, (size_t)256 * 1024 * 2);
    s.n0 = 80 * 22; s.nM0 = 80; s.nN0 = 22; s.a0 = p.ws + OFF_H; s.b0 = p.ws + OFF_W16 + woff;
    EpiFfnIn epi{(bf16_t*)(p.ws + OFF_ACT)};
    pg8::gemm_phase<256>(lds, 1024, 1024, s, epi, wv);
}
__device__ void ffn_out_phase(PRef p, size_t woff, LAS unsigned char* lds, int wv) {
    Sched3 s = make_sched(blockIdx.x, gridDim.x, (size_t)256 * DFF * 2, (size_t)256 * DFF * 2);
    s.n0 = 80 * 4; s.nM0 = 80; s.nN0 = 4; s.a0 = p.ws + OFF_ACT; s.b0 = p.ws + OFF_W16 + woff;
    EpiBf16Y epi{(bf16_t*)(p.ws + OFF_Y)};
    pg8::gemm_phase<256>(lds, DFF, DFF, s, epi, wv);
}
__device__ void gla_in_phase(PRef p, LAS unsigned char* lds, int wv) {
    Sched3 s = make_sched(blockIdx.x, gridDim.x, (size_t)256 * 1024 * 2, (size_t)256 * 1024 * 2);
    s.n0 = 80 * 9; s.nM0 = 80; s.nN0 = 9; s.a0 = p.ws + OFF_H; s.b0 = p.ws + OFF_W16 + WO_GLA_IN; s.bskip_from = 4; s.bskip_by = 4;
    s.n1 = 4 * 80; s.nM1 = 4; s.nN1 = 80; s.a1 = p.ws + OFF_W16 + WO_GLA_IN + (size_t)1024 * 1024 * 2; s.b1 = p.ws + OFF_H;
    EpiGlaIn epi{(bf16_t*)(p.ws + OFF_QK), (bf16_t*)(p.ws + OFF_R), (float*)(p.ws + OFF_Z), (bf16_t*)(p.ws + OFF_GVT)};
    pg8::gemm_phase<256>(lds, 1024, 1024, s, epi, wv);
}
__device__ void gla_out_phase(PRef p, LAS unsigned char* lds, int wv) {
    Sched3 s = make_sched(blockIdx.x, gridDim.x, (size_t)256 * 1024 * 2, (size_t)256 * 1024 * 2);
    s.n0 = 80 * 4; s.nM0 = 80; s.nN0 = 4; s.a0 = p.ws + OFF_QK; s.b0 = p.ws + OFF_W16 + WO_GLA_OUT;
    EpiBf16Y epi{(bf16_t*)(p.ws + OFF_Y)};
    pg8::gemm_phase<256>(lds, 1024, 1024, s, epi, wv);
}
__device__ void mla_in_phase(PRef p, LAS unsigned char* lds, int wv) {
    Sched3 s = make_sched(blockIdx.x, gridDim.x, (size_t)256 * 1024 * 2, (size_t)256 * 1024 * 2);
    s.n0 = 80 * 4; s.nM0 = 80; s.nN0 = 4; s.a0 = p.ws + OFF_H; s.b0 = p.ws + OFF_W16 + WO_MLA_IN;
    EpiF32 epi{(float*)(p.ws + OFF_PM), 832, 832};
    pg8::gemm_phase<256>(lds, 1024, 1024, s, epi, wv);
}
__device__ void mla_proj_phase(PRef p, int q0, int nq, int k0, int nkv, LAS unsigned char* lds, int wv) {
    {
        Sched3 s = make_sched(blockIdx.x, gridDim.x, (size_t)256 * 512 * 2, (size_t)256 * 512 * 2);
        s.n0 = (nq / 256) * 12; s.nM0 = nq / 256; s.nN0 = 12; s.a0 = p.ws + OFF_CQN + (size_t)q0 * 512 * 2; s.b0 = p.ws + OFF_W16 + WO_MLA_UQ;
        EpiMlaQ epi{(bf16_t*)(p.ws + OFF_Q), q0, (const float*)(p.ws + OFF_ROPE)};
        pg8::gemm_phase<256>(lds, 512, 512, s, epi, wv);
    }
    {
        Sched3 s = make_sched(gridDim.x - 1 - blockIdx.x, gridDim.x, (size_t)256 * 256 * 2, (size_t)256 * 256 * 2);
        const char* ckv = p.ws + OFF_CKV + (size_t)k0 * 256 * 2;
        const char* w = p.ws + OFF_W16 + WO_MLA_UKV;
        s.n0 = (nkv / 256) * 8; s.nM0 = nkv / 256; s.nN0 = 8; s.a0 = ckv; s.b0 = w;
        s.n1 = 8 * (nkv / 256); s.nM1 = 8; s.nN1 = nkv / 256; s.a1 = w + (size_t)2048 * 256 * 2; s.b1 = ckv;
        EpiMlaKv epi{(bf16_t*)(p.ws + OFF_KN), (bf16_t*)(p.ws + OFF_MVT)};
        pg8::gemm_phase<256>(lds, 256, 256, s, epi, wv);
    }
}
__device__ void mla_out_phase(PRef p, int q0, int nq, LAS unsigned char* lds, int wv) {
    Sched3 s = make_sched(blockIdx.x, gridDim.x, (size_t)256 * 3072 * 2, (size_t)256 * 2048 * 2);
    s.n0 = (nq / 256) * 4; s.nM0 = nq / 256; s.nN0 = 4; s.a0 = p.ws + OFF_Q; s.b0 = p.ws + OFF_W16 + WO_MLA_OUT;
    EpiBf16Y epi{(bf16_t*)(p.ws + OFF_Y) + (size_t)q0 * 1024};
    pg8::gemm_phase<384>(lds, 2048, 3072, s, epi, wv);
}

__device__ __forceinline__ float gla_logdecay(float logit) {
    return (fminf(logit, 0.f) - __logf(1.f + __expf(-fabsf(logit)))) * (1.f / 16.f);
}

#define GATE_BAR() do { asm volatile("s_waitcnt lgkmcnt(0)" ::: "memory"); __builtin_amdgcn_s_barrier(); asm volatile("" ::: "memory"); } while (0)
__device__ void gla_gate_phase(PRef p, char* lds0, int wv) {
    const int TIDX = otid(wv);
    const int hw = TIDX >> 8, tid = TIDX & 255;
    char* lds = lds0 + hw * 57344;
    float* zs = (float*)lds;
    float* tot = (float*)(lds + 4096);
    bf16_t* QFl = (bf16_t*)(lds + 8192);
    bf16_t* KFl = (bf16_t*)(lds + 8192 + 16384);
    bf16_t* KQl = (bf16_t*)(lds + 8192 + 32768);
    const int lane = tid & 63, w = tid >> 6, l15 = lane & 15, quad = lane >> 4;
    const int dk = tid & 127, hf = tid >> 7;
    const bf16_t* QK = (const bf16_t*)(p.ws + OFF_QK);
    const float* Z = (const float*)(p.ws + OFF_Z);
    bf16_t* QF = (bf16_t*)(p.ws + OFF_QF);
    bf16_t* KF = (bf16_t*)(p.ws + OFF_KF);
    bf16_t* AF = (bf16_t*)(p.ws + OFF_AF);
    float* DEC = (float*)(p.ws + OFF_DEC);
    for (int it2 = blockIdx.x; it2 < 1280; it2 += gridDim.x) {
        const int it = it2 * 2 + hw;
        const int dir = it & 1, head = (it >> 1) & 3, gch = it >> 3;
        GATE_BAR();
        {
            const int tok = tid >> 2, r4 = (tid & 3) * 4;
            *(f32x4*)(zs + tok * 16 + r4) = *(const f32x4*)(Z + (size_t)(gch * 64 + tok) * 32 + dir * 16 + r4);
        }
        {
#pragma unroll
            for (int j = 0; j < 8; ++j) {
                const int ci = tid + 256 * j;
                const int isk = ci >> 10, tok = (ci >> 4) & 63, ch = ci & 15, dk0 = ch * 8;
                const u32x4 v = *(const u32x4*)(QK + (size_t)(gch * 64 + tok) * 1024 + isk * 512 + head * 128 + dk0);
                bf16_t* dst = isk ? KQl : QFl;
                const int base = ((((tok >> 4) * 4 + (dk0 >> 5)) * 64 + (tok & 15)) << 3) + ((dk0 >> 4) & 1) * 4;
                const int q0 = (dk0 & 15) >> 2;
                u32x2 lo, hi; lo.x = v.x; lo.y = v.y; hi.x = v.z; hi.y = v.w;
                *(u32x2*)(dst + base + ((q0 * 16) << 3)) = lo;
                *(u32x2*)(dst + base + (((q0 + 1) * 16) << 3)) = hi;
            }
        }
        float wg[16];
#pragma unroll
        for (int r = 0; r < 16; ++r) wg[r] = p.gla_w_gate[((size_t)dir * 16 + r) * 512 + head * 128 + dk];
        const float bg = p.gla_b_gate[dir * 512 + head * 128 + dk];
        GATE_BAR();
        float sum = 0.f;
        float gv[32];
#pragma unroll
        for (int s2 = 0; s2 < 32; ++s2) {
            const int s = hf * 32 + s2;
            const int tok = dir ? 63 - s : s;
            float lg = bg;
#pragma unroll
            for (int r = 0; r < 16; ++r) lg = fmaf(zs[tok * 16 + r], wg[r], lg);
            gv[s2] = gla_logdecay(lg);
            sum += gv[s2];
        }
        tot[hf * 128 + dk] = sum;
        GATE_BAR();
        float run = hf ? tot[dk] : 0.f;
        if (hf == 0) DEC[(size_t)it * 128 + dk] = __expf(tot[dk] + tot[128 + dk]);
#pragma unroll
        for (int s2 = 0; s2 < 32; ++s2) {
            const int s = hf * 32 + s2;
            const int tok = dir ? 63 - s : s;
            run += gv[s2];
            const int qi = ((((tok >> 4) * 4 + (dk >> 5)) * 64 + ((dk & 15) >> 2) * 16 + (tok & 15)) << 3) + ((dk >> 4) & 1) * 4 + (dk & 3);
            const float qv = bf2f(QFl[qi]) * 0.08838834764831845f * __expf(run);
            const float kv = bf2f(KQl[qi]) * __expf(-run);
            const int ki = ((((dk >> 4) * 2 + (tok >> 5)) * 64 + ((tok & 15) >> 2) * 16 + (dk & 15)) << 3) + ((tok >> 4) & 1) * 4 + (tok & 3);
            const bf16_t kb = f2bf(kv);
            QFl[qi] = f2bf(qv);
            KQl[qi] = kb;
            KFl[ki] = kb;
        }
        GATE_BAR();
        {
            f32x4 s[4];
#pragma unroll
            for (int mb = 0; mb < 4; ++mb) s[mb] = (f32x4){0.f, 0.f, 0.f, 0.f};
#pragma unroll
            for (int ks = 0; ks < 4; ++ks) {
                const bf16x8 qf = *(const bf16x8*)(QFl + ((w * 4 + ks) * 64 + lane) * 8);
#pragma unroll
                for (int mb = 0; mb < 4; ++mb) {
                    const bf16x8 kf = *(const bf16x8*)(KQl + ((mb * 4 + ks) * 64 + lane) * 8);
                    s[mb] = mfma16(kf, qf, s[mb]);
                }
            }
            const int i = w * 16 + l15;
#pragma unroll
            for (int mb = 0; mb < 4; ++mb)
#pragma unroll
                for (int r = 0; r < 4; ++r) {
                    const int j = mb * 16 + quad * 4 + r;
                    const bool keep = dir ? (j >= i) : (j <= i);
                    if (!keep) s[mb][r] = 0.f;
                }
#pragma unroll
            for (int pp = 0; pp < 2; ++pp) {
                u32x4 o;
                o.x = pk2(s[2 * pp][0], s[2 * pp][1]); o.y = pk2(s[2 * pp][2], s[2 * pp][3]);
                o.z = pk2(s[2 * pp + 1][0], s[2 * pp + 1][1]); o.w = pk2(s[2 * pp + 1][2], s[2 * pp + 1][3]);
                *(u32x4*)(AF + (size_t)it * 4096 + ((w * 2 + pp) * 64 + lane) * 8) = o;
            }
        }
#pragma unroll
        for (int j = 0; j < 4; ++j) {
            const int ci = tid + 256 * j;
            *(u32x4*)(QF + (size_t)it * 8192 + ci * 8) = *(const u32x4*)(QFl + ci * 8);
            *(u32x4*)(KF + (size_t)it * 8192 + ci * 8) = *(const u32x4*)(KFl + ci * 8);
        }
    }
}

#define LDS_BARRIER_() do { asm volatile("s_waitcnt lgkmcnt(0)" ::: "memory"); __builtin_amdgcn_s_barrier(); asm volatile("" ::: "memory"); } while (0)
__device__ void gla_scan_phase(PRef p, char* lds0, int wv) {
    const int TIDX = otid(wv);
    const int hw = TIDX >> 8, tid = TIDX & 255;
    char* lds = lds0 + hw * 41472;
    bf16_t* KFl = (bf16_t*)lds;
    bf16_t* VFl = (bf16_t*)(lds + 16384);
    bf16_t* HB = (bf16_t*)(lds + 24576);
    float* DCl = (float*)(lds + 40960);
    const int lane = tid & 63, w = tid >> 6, l15 = lane & 15, quad = lane >> 4;
    bf16_t* OSl = (bf16_t*)(lds0 + 82944 + (TIDX >> 6) * 2304);
    const bf16_t* QF = (const bf16_t*)(p.ws + OFF_QF);
    const bf16_t* KF = (const bf16_t*)(p.ws + OFF_KF);
    const bf16_t* AF = (const bf16_t*)(p.ws + OFF_AF);
    const bf16_t* VT = (const bf16_t*)(p.ws + OFF_GVT);
    const float* DEC = (const float*)(p.ws + OFF_DEC);
    bf16_t* OF = (bf16_t*)(p.ws + OFF_OF);
    for (int vrt = blockIdx.x; vrt < 512; vrt += gridDim.x) {
        const int vb = vrt & 255, rnd = vrt >> 8;
        if (rnd == 1 && vb >= 128) continue;
        int b, rem, nch, gch0, dir; bool active; const bool lat = vb >= 128;
        if (lat) { const int c = vb - 128, xcd = c & 7, slot = c >> 3, pair = xcd * 2 + (slot >> 3), within = slot & 7;
                   b = pair >> 2; rem = ((pair & 3) << 2) | (within & 3); dir = within >> 2; nch = 64; gch0 = 64 + b * 64; active = hw == 0; }
        else { const int u = rnd * 128 + vb; b = u >> 4; rem = u & 15; dir = hw; nch = 4; gch0 = b * 4; active = true; }
        const int head = rem >> 2, s4 = rem & 3;
        if (!active) {
            __syncthreads();
            for (int s = 0; s < nch; ++s) { LDS_BARRIER_(); LDS_BARRIER_(); }
            continue;
        }
        f32x4 st[8];
        if (lat) {
            const float* sp = p.state_gla + (((size_t)b * 2 + dir) * 4 + head) * 32768 + s4 * 64 + w * 16 + l15;
#pragma unroll
            for (int mb = 0; mb < 8; ++mb)
#pragma unroll
                for (int r = 0; r < 4; ++r) st[mb][r] = sp[(size_t)(mb * 16 + quad * 4 + r) * 256];
        } else {
#pragma unroll
            for (int mb = 0; mb < 8; ++mb) st[mb] = (f32x4){0.f, 0.f, 0.f, 0.f};
        }
        __syncthreads();
#pragma unroll
        for (int ks = 0; ks < 4; ++ks) {
            u32x4 o;
            o.x = pk2(st[2 * ks][0], st[2 * ks][1]); o.y = pk2(st[2 * ks][2], st[2 * ks][3]);
            o.z = pk2(st[2 * ks + 1][0], st[2 * ks + 1][1]); o.w = pk2(st[2 * ks + 1][2], st[2 * ks + 1][3]);
            *(u32x4*)(HB + ((w * 4 + ks) * 64 + lane) * 8) = o;
        }
        u32x4 rK0[4], rV0[2], rQ0[4], rA0[2]; f32x4 rD0;
#define SCAN_LOAD(step, rK, rV, rQ, rA, rD) { const int c_ = dir ? nch - 1 - (step) : (step); const size_t gi_ = ((size_t)(gch0 + c_) * 4 + head) * 2 + dir; \
    _Pragma("unroll") for (int j = 0; j < 4; ++j) rK[j] = *(const u32x4*)(KF + gi_ * 8192 + (tid + 256 * j) * 8); \
    _Pragma("unroll") for (int j = 0; j < 2; ++j) rV[j] = *(const u32x4*)(VT + ((size_t)(gch0 + c_) * 4 + head) * 16384 + s4 * 4096 + (tid + 256 * j) * 8); \
    _Pragma("unroll") for (int j = 0; j < 4; ++j) rQ[j] = *(const u32x4*)(QF + gi_ * 8192 + ((w * 4 + j) * 64 + lane) * 8); \
    _Pragma("unroll") for (int j = 0; j < 2; ++j) rA[j] = *(const u32x4*)(AF + gi_ * 4096 + ((w * 2 + j) * 64 + lane) * 8); \
    if (tid < 32) rD = *(const f32x4*)(DEC + gi_ * 128 + tid * 4); }
#define LDS_BARRIER() do { asm volatile("s_waitcnt lgkmcnt(0)" ::: "memory"); __builtin_amdgcn_s_barrier(); asm volatile("" ::: "memory"); } while (0)
#define SCAN_STEP(s, rK, rV, rQ, rA, rD) { \
            const int c = dir ? nch - 1 - (s) : (s); \
            _Pragma("unroll") for (int j = 0; j < 4; ++j) *(u32x4*)(KFl + (tid + 256 * j) * 8) = rK[j]; \
            _Pragma("unroll") for (int j = 0; j < 2; ++j) *(u32x4*)(VFl + (tid + 256 * j) * 8) = rV[j]; \
            if (tid < 32) *(f32x4*)(DCl + tid * 4) = rD; \
            bf16x8 qf[4], af[2]; \
            _Pragma("unroll") for (int j = 0; j < 4; ++j) qf[j] = as_bf8(rQ[j]); \
            _Pragma("unroll") for (int j = 0; j < 2; ++j) af[j] = as_bf8(rA[j]); \
            LDS_BARRIER(); \
            if ((s) + 1 < nch) SCAN_LOAD((s) + 1, rK, rV, rQ, rA, rD); \
            f32x4 acc[4]; \
            _Pragma("unroll") for (int nb = 0; nb < 4; ++nb) acc[nb] = (f32x4){0.f, 0.f, 0.f, 0.f}; \
            { bf16x8 fr_[8]; \
              _Pragma("unroll") for (int pp = 0; pp < 2; ++pp) _Pragma("unroll") for (int nb = 0; nb < 4; ++nb) fr_[pp * 4 + nb] = *(const bf16x8*)(VFl + ((nb * 2 + pp) * 64 + lane) * 8); \
              _Pragma("unroll") for (int pp = 0; pp < 2; ++pp) _Pragma("unroll") for (int nb = 0; nb < 4; ++nb) acc[nb] = mfma16(af[pp], fr_[pp * 4 + nb], acc[nb]); } \
            _Pragma("unroll") for (int kh = 0; kh < 2; ++kh) { bf16x8 fr_[8]; \
              _Pragma("unroll") for (int k2 = 0; k2 < 2; ++k2) _Pragma("unroll") for (int nb = 0; nb < 4; ++nb) fr_[k2 * 4 + nb] = *(const bf16x8*)(HB + ((nb * 4 + kh * 2 + k2) * 64 + lane) * 8); \
              _Pragma("unroll") for (int k2 = 0; k2 < 2; ++k2) _Pragma("unroll") for (int nb = 0; nb < 4; ++nb) acc[nb] = mfma16(qf[kh * 2 + k2], fr_[k2 * 4 + nb], acc[nb]); } \
            {     \
                _Pragma("unroll") for (int nb = 0; nb < 4; ++nb) \
                    _Pragma("unroll") for (int r = 0; r < 4; ++r) OSl[(quad * 4 + r) * 72 + nb * 16 + l15] = f2bf(acc[nb][r]); \
                bf16_t* op = OF + (size_t)dir * T * 1024 + (size_t)((gch0 + c) * 64 + w * 16) * 1024 + head * 256 + s4 * 64; \
                _Pragma("unroll") for (int j = 0; j < 2; ++j) { const int id_ = lane + 64 * j, row_ = id_ >> 3, ch_ = id_ & 7; \
                    *(u32x4*)(op + (size_t)row_ * 1024 + ch_ * 8) = *(const u32x4*)(OSl + row_ * 72 + ch_ * 8); } \
            } \
            bf16x8 vw[2]; \
            _Pragma("unroll") for (int pp = 0; pp < 2; ++pp) vw[pp] = *(const bf16x8*)(VFl + ((w * 2 + pp) * 64 + lane) * 8); \
            _Pragma("unroll") for (int mh = 0; mh < 2; ++mh) { bf16x8 fr_[8]; f32x4 dc_[4]; \
              _Pragma("unroll") for (int m2 = 0; m2 < 4; ++m2) { _Pragma("unroll") for (int pp = 0; pp < 2; ++pp) fr_[m2 * 2 + pp] = *(const bf16x8*)(KFl + (((mh * 4 + m2) * 2 + pp) * 64 + lane) * 8); \
                                                                  dc_[m2] = *(const f32x4*)(DCl + (mh * 4 + m2) * 16 + quad * 4); } \
              _Pragma("unroll") for (int m2 = 0; m2 < 4; ++m2) { f32x4 a = st[mh * 4 + m2]; \
                _Pragma("unroll") for (int pp = 0; pp < 2; ++pp) a = mfma16(fr_[m2 * 2 + pp], vw[pp], a); \
                st[mh * 4 + m2] = a * dc_[m2]; } } \
            LDS_BARRIER(); \
            _Pragma("unroll") for (int ks = 0; ks < 4; ++ks) { \
                u32x4 o; \
                o.x = pk2(st[2 * ks][0], st[2 * ks][1]); o.y = pk2(st[2 * ks][2], st[2 * ks][3]); \
                o.z = pk2(st[2 * ks + 1][0], st[2 * ks + 1][1]); o.w = pk2(st[2 * ks + 1][2], st[2 * ks + 1][3]); \
                *(u32x4*)(HB + ((w * 4 + ks) * 64 + lane) * 8) = o; \
            } }
        SCAN_LOAD(0, rK0, rV0, rQ0, rA0, rD0);
        for (int s = 0; s < nch; ++s) {
            SCAN_STEP(s, rK0, rV0, rQ0, rA0, rD0);
        }
#undef SCAN_STEP
#undef SCAN_LOAD
        if (!lat) {
            float* sp = p.out + OUT_STATE + (((size_t)b * 2 + dir) * 4 + head) * 32768 + s4 * 64 + w * 16 + l15;
#pragma unroll
            for (int mb = 0; mb < 8; ++mb)
#pragma unroll
                for (int r = 0; r < 4; ++r) sp[(size_t)(mb * 16 + quad * 4 + r) * 256] = st[mb][r];
        }
    }
}

__device__ void gla_post_phase(PRef p, int wv) {
    const int TIDX = otid(wv);
    const int lane = TIDX & 63, w = TIDX >> 6;
    const bf16_t* OF = (const bf16_t*)(p.ws + OFF_OF);
    const bf16_t* R = (const bf16_t*)(p.ws + OFF_R);
    bf16_t* OG = (bf16_t*)(p.ws + OFF_QK);
    float go[16];
#pragma unroll
    for (int e = 0; e < 4; ++e) { const f32x4 g4 = *(const f32x4*)(p.gla_g_out + lane * 16 + e * 4); go[e * 4] = g4[0]; go[e * 4 + 1] = g4[1]; go[e * 4 + 2] = g4[2]; go[e * 4 + 3] = g4[3]; }
    for (int it = blockIdx.x; it < T / 40; it += gridDim.x) {
#pragma unroll
        for (int rr = 0; rr < 5; ++rr) {
            const size_t t = it * 40 + w * 5 + rr;
            const size_t o0 = t * 1024 + lane * 16;
            float v[16];
            float ss = 0.f;
#pragma unroll
            for (int hh = 0; hh < 2; ++hh) {
                const u32x4 a = *(const u32x4*)(OF + o0 + hh * 8), b = *(const u32x4*)(OF + (size_t)T * 1024 + o0 + hh * 8);
#pragma unroll
                for (int e = 0; e < 4; ++e) {
                    v[hh * 8 + e * 2] = bflo(a[e]) + bflo(b[e]);
                    v[hh * 8 + e * 2 + 1] = bfhi(a[e]) + bfhi(b[e]);
                }
            }
#pragma unroll
            for (int e = 0; e < 16; ++e) ss += v[e] * v[e];
#pragma unroll
            for (int o = 8; o; o >>= 1) ss += __shfl_xor(ss, o);
            const float rs = rsqrtf(ss * (1.f / 256.f) + EPS);
#pragma unroll
            for (int hh = 0; hh < 2; ++hh) {
                const u32x4 rv = *(const u32x4*)(R + o0 + hh * 8);
                u32x4 o;
#pragma unroll
                for (int e = 0; e < 4; ++e) {
                    const int i0 = hh * 8 + e * 2;
                    const float g0 = go[i0], g1 = go[i0 + 1];
                    o[e] = pk2(v[i0] * rs * g0 * silu_f(bflo(rv[e])), v[i0 + 1] * rs * g1 * silu_f(bfhi(rv[e])));
                }
                *(u32x4*)(OG + o0 + hh * 8) = o;
            }
        }
    }
}

__device__ __forceinline__ int kv_row_of(int t) {
    if (t < T_CTX) return t;
    const int b = (t - T_CTX) >> 12, s = (t - T_CTX) & 4095;
    return T_CTX + b * 4352 + 256 + s;
}

__device__ void mla_row_phase(PRef p, int wv) {
    const int TIDX = otid(wv);
    const int lane = TIDX & 63, w = TIDX >> 6;
    const float* PM = (const float*)(p.ws + OFF_PM);
    bf16_t* CQN = (bf16_t*)(p.ws + OFF_CQN);
    bf16_t* CKV = (bf16_t*)(p.ws + OFF_CKV);
    bf16_t* KR = (bf16_t*)(p.ws + OFF_KR);
    const float* rope = (const float*)(p.ws + OFF_ROPE);
    const int nrows = T + 1024;
    for (int it = blockIdx.x; it < nrows / 32; it += gridDim.x) {
#pragma unroll
        for (int rr = 0; rr < 4; ++rr) {
            const int t = it * 32 + w * 4 + rr;
            if (t >= T) {
                const int j = t - T, b = j >> 8, s = j & 255;
                const int kvr = T_CTX + b * 4352 + s;
                const f32x4 v = *(const f32x4*)(p.cache_ckv + (size_t)j * 256 + lane * 4);
                *(u32x2*)(CKV + (size_t)kvr * 256 + lane * 4) = pk4(v);
                KR[(size_t)kvr * 64 + lane] = f2bf(p.cache_kr[(size_t)j * 64 + lane]);
                continue;
            }
            const float* pr = PM + (size_t)t * 832;
            const int kvr = kv_row_of(t);
            {
                const f32x4 a = *(const f32x4*)(pr + lane * 8), b = *(const f32x4*)(pr + lane * 8 + 4);
                float ss = a[0] * a[0] + a[1] * a[1] + a[2] * a[2] + a[3] * a[3] + b[0] * b[0] + b[1] * b[1] + b[2] * b[2] + b[3] * b[3];
                ss = wave_sum(ss);
                const float rs = rsqrtf(ss * (1.f / 512.f) + EPS);
                const f32x4 ga = *(const f32x4*)(p.mla_g_q + lane * 8), gb = *(const f32x4*)(p.mla_g_q + lane * 8 + 4);
                u32x4 o;
                o.x = pk2(a[0] * rs * ga[0], a[1] * rs * ga[1]); o.y = pk2(a[2] * rs * ga[2], a[3] * rs * ga[3]);
                o.z = pk2(b[0] * rs * gb[0], b[1] * rs * gb[1]); o.w = pk2(b[2] * rs * gb[2], b[3] * rs * gb[3]);
                *(u32x4*)(CQN + (size_t)t * 512 + lane * 8) = o;
            }
            {
                const f32x4 a = *(const f32x4*)(pr + 512 + lane * 4);
                float ss = a[0] * a[0] + a[1] * a[1] + a[2] * a[2] + a[3] * a[3];
                ss = wave_sum(ss);
                const float rs = rsqrtf(ss * (1.f / 256.f) + EPS);
                const f32x4 g = *(const f32x4*)(p.mla_g_kv + lane * 4);
                const f32x4 n = a * rs * g;
                *(u32x2*)(CKV + (size_t)kvr * 256 + lane * 4) = pk4(n);
                if (t < T_CTX) *(f32x4*)(p.out + OUT_CKV + (size_t)t * 256 + lane * 4) = n;
            }
            {
                float v = pr[768 + lane];
                if (t < T_CTX) {
                    p.out[OUT_KR + (size_t)t * 64 + lane] = v;
                } else {
                    const int s = (t - T_CTX) & 4095;
                    const int pos = (lane & 32) ? (s & 63) : (s >> 6);
                    const int f = lane & 15;
                    const float cs = rope[(pos * 16 + f) * 2], sn = rope[(pos * 16 + f) * 2 + 1];
                    const float o = __shfl_xor(v, 16);
                    v = (lane & 16) ? (v * cs + o * sn) : (v * cs - o * sn);
                }
                KR[(size_t)kvr * 64 + lane] = f2bf(v);
            }
        }
    }
}

__device__ __forceinline__ void mla_attn_item(PRef p, int qrow0, int head, int kt0, int ntiles, int krow0, char* lds, bool dry, int wv) {
    const int TIDX = otid(wv);
    const int tid = TIDX, lane = tid & 63, w = tid >> 6, l15 = lane & 15, quad = lane >> 4;
    bf16_t* Q = (bf16_t*)(p.ws + OFF_Q);
    const bf16_t* KN = (const bf16_t*)(p.ws + OFF_KN);
    const bf16_t* KR = (const bf16_t*)(p.ws + OFF_KR);
    const bf16_t* VT = (const bf16_t*)(p.ws + OFF_MVT);
    bf16x8 qf[2][6];
#pragma unroll
    for (int nb = 0; nb < 2; ++nb)
#pragma unroll
        for (int ks = 0; ks < 6; ++ks)
            qf[nb][ks] = *(const bf16x8*)(Q + (size_t)(qrow0 + w * 32 + nb * 16 + l15) * 3072 + head * 192 + ks * 32 + quad * 8);
    f32x4 o[8][2];
#pragma unroll
    for (int i = 0; i < 8; ++i) { o[i][0] = (f32x4){0.f, 0.f, 0.f, 0.f}; o[i][1] = (f32x4){0.f, 0.f, 0.f, 0.f}; }
    float mrow[2] = {0.f, 0.f}, lsum[2] = {0.f, 0.f};
    const int wvu = __builtin_amdgcn_readfirstlane(w);
    const char* ksrc[3]; int kstep_[3];
#pragma unroll
    for (int j = 0; j < 3; ++j) {
        const int q = (j * 8 + wvu) * 64 + lane;
        const int row = q / 24, cp = q - row * 24;
        const int c = (cp & 24) | ((cp ^ row) & 7);
        if (c < 16) { ksrc[j] = (const char*)(KN + (size_t)(kt0 * 64 + row) * 2048 + head * 128 + c * 8); kstep_[j] = 64 * 2048 * 2; }
        else        { ksrc[j] = (const char*)(KR + (size_t)(krow0 + row) * 64 + (c - 16) * 8); kstep_[j] = 64 * 64 * 2; }
    }
    const char* vsrc = (const char*)(VT + ((size_t)kt0 * 16 + head) * 8192 + (size_t)(wvu * 64 + lane) * 8);
    LAS unsigned char* ldsl = (LAS unsigned char*)lds;
    const int kb0 = l15 * 384 + ((quad ^ (l15 & 7)) << 4), kb1 = l15 * 384 + (((quad ^ (l15 & 7)) ^ 4) << 4);
#define ATT_STAGE(tile, buf) { \
    _Pragma("unroll") for (int j = 0; j < 3; ++j) \
        __builtin_amdgcn_global_load_lds((const unsigned*)(ksrc[j] + (size_t)(tile) * kstep_[j]), (LAS unsigned*)(ldsl + (buf) * 40960 + (j * 8 + wvu) * 1024), 16, 0, 0); \
    _Pragma("unroll") for (int j = 0; j < 2; ++j) \
        __builtin_amdgcn_global_load_lds((const unsigned*)(vsrc + (size_t)(tile) * (16 * 8192 * 2) + j * 8192), (LAS unsigned*)(ldsl + (buf) * 40960 + 24576 + (j * 8 + wvu) * 1024), 16, 0, 0); }
    __syncthreads();
    ATT_STAGE(0, 0);
    asm volatile("s_waitcnt vmcnt(0)" ::: "memory");
    __syncthreads();
    for (int tl = 0; tl < ntiles; ++tl) {
        const char* Kb = lds + (tl & 1) * 40960;
        const char* Vb = Kb + 24576;
        if (tl + 1 < ntiles) ATT_STAGE(tl + 1, (tl + 1) & 1);
        f32x4 s[2][2][2];
#pragma unroll
        for (int hk = 0; hk < 2; ++hk)
#pragma unroll
            for (int mb = 0; mb < 2; ++mb) { s[hk][mb][0] = (f32x4){-mrow[0], -mrow[0], -mrow[0], -mrow[0]}; s[hk][mb][1] = (f32x4){-mrow[1], -mrow[1], -mrow[1], -mrow[1]}; }
#pragma unroll
        for (int hk = 0; hk < 2; ++hk)
#pragma unroll
            for (int mb = 0; mb < 2; ++mb) {
                bf16x8 kf[6];
#pragma unroll
                for (int ks = 0; ks < 6; ++ks) kf[ks] = *(const bf16x8*)(Kb + hk * 12288 + ((ks & 1) ? kb1 : kb0) + mb * 6144 + (ks >> 1) * 128);
#pragma unroll
                for (int ks = 0; ks < 6; ++ks) {
                    s[hk][mb][0] = mfma16(kf[ks], qf[0][ks], s[hk][mb][0]);
                    s[hk][mb][1] = mfma16(kf[ks], qf[1][ks], s[hk][mb][1]);
                }
            }
        float mxt[2] = {-1e30f, -1e30f};
#pragma unroll
        for (int hk = 0; hk < 2; ++hk) {
            bf16x8 pf[2];
#pragma unroll
            for (int nb = 0; nb < 2; ++nb) {
                const float mx = fmaxf(fmaxf(fmaxf(s[hk][0][nb][0], s[hk][0][nb][1]), fmaxf(s[hk][0][nb][2], s[hk][0][nb][3])), fmaxf(fmaxf(s[hk][1][nb][0], s[hk][1][nb][1]), fmaxf(s[hk][1][nb][2], s[hk][1][nb][3])));
                mxt[nb] = fmaxf(mxt[nb], mx);
                float ps = 0.f;
#pragma unroll
                for (int mb = 0; mb < 2; ++mb)
#pragma unroll
                    for (int r = 0; r < 4; ++r) { const float pv = __builtin_amdgcn_exp2f(s[hk][mb][nb][r]); s[hk][mb][nb][r] = pv; ps += pv; }
                lsum[nb] += ps;
                u32x4 pk;
                pk.x = pk2(s[hk][0][nb][0], s[hk][0][nb][1]); pk.y = pk2(s[hk][0][nb][2], s[hk][0][nb][3]);
                pk.z = pk2(s[hk][1][nb][0], s[hk][1][nb][1]); pk.w = pk2(s[hk][1][nb][2], s[hk][1][nb][3]);
                pf[nb] = as_bf8(pk);
            }
#pragma unroll
            for (int ih = 0; ih < 2; ++ih) {
                bf16x8 vf[4];
#pragma unroll
                for (int i2 = 0; i2 < 4; ++i2) vf[i2] = *(const bf16x8*)(Vb + (((ih * 4 + i2) * 2 + hk) * 64 + lane) * 16);
#pragma unroll
                for (int i2 = 0; i2 < 4; ++i2) {
                    o[ih * 4 + i2][0] = mfma16(vf[i2], pf[0], o[ih * 4 + i2][0]);
                    o[ih * 4 + i2][1] = mfma16(vf[i2], pf[1], o[ih * 4 + i2][1]);
                }
            }
        }
#pragma unroll
        for (int nb = 0; nb < 2; ++nb) {
            float mx = mxt[nb];
            const auto r16 = __builtin_amdgcn_permlane16_swap(__float_as_uint(mx), __float_as_uint(mx), false, false);
            mx = fmaxf(__uint_as_float(r16[0]), __uint_as_float(r16[1]));
            const auto r32 = __builtin_amdgcn_permlane32_swap(__float_as_uint(mx), __float_as_uint(mx), false, false);
            mx = fmaxf(__uint_as_float(r32[0]), __uint_as_float(r32[1]));
            if (__builtin_amdgcn_ballot_w64(mx > 8.0f) != 0) {
                const float delta = fmaxf(mx, 0.f);
                const float alpha = __builtin_amdgcn_exp2f(-delta);
                mrow[nb] += delta;
                lsum[nb] *= alpha;
#pragma unroll
                for (int i = 0; i < 8; ++i) o[i][nb] *= alpha;
            }
        }
        asm volatile("s_waitcnt vmcnt(0)" ::: "memory");
        __syncthreads();
    }
#undef ATT_STAGE
#pragma unroll
    for (int nb = 0; nb < 2; ++nb) {
        float l = lsum[nb];
        l += __shfl_xor(l, 16);
        l += __shfl_xor(l, 32);
        const float inv = 1.f / l;
        bf16_t* op = Q + (size_t)(qrow0 + w * 32 + nb * 16 + l15) * 3072 + head * 192 + quad * 4;
        if (dry && p.out != nullptr) continue;
#pragma unroll
        for (int i = 0; i < 8; ++i) *(u32x2*)(op + i * 16) = pk4(o[i][nb] * inv);
    }
}

__device__ void mla_attn_phase(PRef p, int g, char* lds, int wv, bool dry = false) {
    const int nlat = 2 * 16 * 16, nctx = g == 0 ? 16 * 16 : 0;
    for (int it = blockIdx.x; it < nlat + nctx; it += gridDim.x) {
        int qrow0, head, kt0, ntiles, krow0;
        if (it < nlat) {
            const int rnd = it >> 8, c = it & 255, xcd = c & 7, slot = c >> 3;
            const int pair = rnd * 16 + xcd + 8 * (slot >> 4), qb = slot & 15;
            const int bl = pair >> 4;
            const int b = g * 2 + bl;
            head = pair & 15;
            qrow0 = (g == 0 ? T_CTX : 0) + bl * 4096 + qb * 256;
            krow0 = T_CTX + b * 4352;
            kt0 = (krow0 - (g == 0 ? 0 : 12800)) >> 6;
            ntiles = 68;
        } else {
            const int u = it - nlat, b = u >> 4;
            head = u & 15;
            qrow0 = b * 256; kt0 = b * 4; ntiles = 4; krow0 = b * 256;
        }
        mla_attn_item(p, qrow0, head, kt0, ntiles, krow0, lds, dry, wv);
    }
}

#define XB_TMO      128
#define XB_XCNT(j)  (256  + 64 * (j))
#define XB_XSUB(j)  (1280 + 64 * (j))
#define XB_XGEN(j)  (2304 + 64 * (j))
#define XB_TOP      3328
#define XB_TOPGEN   3392
#define XB_SPIN_CAP (1u << 18)
__device__ __forceinline__ unsigned xb_ld(unsigned* p)              { return __hip_atomic_load(p, __ATOMIC_RELAXED, __HIP_MEMORY_SCOPE_AGENT); }
__device__ __forceinline__ unsigned xb_add(unsigned* p, unsigned v) { return __hip_atomic_fetch_add(p, v, __ATOMIC_RELAXED, __HIP_MEMORY_SCOPE_AGENT); }
__device__ __forceinline__ unsigned xb_xcc_id() { return (unsigned)__builtin_amdgcn_s_getreg((3 << 11) | 20) & 0xFu; }
#define XB_SPIN(cond, bar) do { unsigned _sp = 0; while (cond) { __builtin_amdgcn_s_sleep(1); \
    if ((++_sp & 255u) == 0u) { if (xb_ld(&(bar)[XB_TMO])) break; if (_sp > XB_SPIN_CAP) { atomicAdd(&(bar)[XB_TMO], 1u); break; } } } } while (0)
__device__ __forceinline__ void xcd_barrier_complete(unsigned* bar, unsigned x, unsigned& nloc, unsigned& nx) {
    const unsigned G = gridDim.x;
    unsigned sum, cnt, mine, sp = 0u;
    for (;;) {
        sum = 0u; cnt = 0u; mine = 0u;
#pragma unroll
        for (unsigned j = 0; j < 16; ++j) { const unsigned c = xb_ld(&bar[XB_XCNT(j)]); sum += c; cnt += (c > 0u) ? 1u : 0u; mine = (j == x) ? c : mine; }
        if (sum == G) break;
        __builtin_amdgcn_s_sleep(1);
        if ((++sp & 255u) == 0u) { if (xb_ld(&bar[XB_TMO])) break; if (sp > XB_SPIN_CAP) { atomicAdd(&bar[XB_TMO], 1u); break; } }
    }
    nloc = mine > 0u ? mine : 1u; nx = cnt > 0u ? cnt : 1u;
}
__device__ __forceinline__ void xcd_barrier(unsigned* bar, volatile LAS unsigned* st, int wv) {
    asm volatile("s_waitcnt vmcnt(0)" ::: "memory");
    __syncthreads();
    if (otid(wv) == 0) {
        const unsigned x = xb_xcc_id();
        __builtin_amdgcn_s_waitcnt(0);
        unsigned nloc = st[0], nx = st[1];
        if (nloc == 0u) { xcd_barrier_complete(bar, x, nloc, nx); st[0] = nloc; st[1] = nx; }
        const unsigned old = xb_add(&bar[XB_XSUB(x)], 1u);
        const unsigned gen = old / nloc;
        if (old + 1u == (gen + 1u) * nloc) {
            __builtin_amdgcn_fence(__ATOMIC_RELEASE, "agent");
            asm volatile("s_waitcnt vmcnt(0)" ::: "memory");
            const unsigned og = xb_add(&bar[XB_TOP], 1u);
            const unsigned tg = og / nx;
            if (og + 1u == (tg + 1u) * nx) xb_add(&bar[XB_TOPGEN], 1u);
            else XB_SPIN(xb_ld(&bar[XB_TOPGEN]) == tg, bar);
            __builtin_amdgcn_fence(__ATOMIC_ACQUIRE, "agent");
            xb_add(&bar[XB_XGEN(x)], 1u);
            asm volatile("s_waitcnt vmcnt(0)" ::: "memory");
        } else {
            XB_SPIN(xb_ld(&bar[XB_XGEN(x)]) == gen, bar);
            __builtin_amdgcn_fence(__ATOMIC_ACQUIRE, "agent");
            asm volatile("s_waitcnt vmcnt(0)" ::: "memory");
        }
    }
    __syncthreads();
}

__device__ __forceinline__ const __attribute__((address_space(4))) Params* kparams() {
    const __attribute__((address_space(4))) Params* kp = (const __attribute__((address_space(4))) Params*)__builtin_amdgcn_kernarg_segment_ptr();
    asm volatile("" : "+s"(kp));
    return kp;
}
__device__ const unsigned char PROG[29][2] = {
    {0, 0}, {1, 0}, {2, 0}, {3, 0}, {1, 1}, {4, 0}, {5, 0}, {6, 0}, {7, 0}, {8, 0}, {1, 2}, {2, 1}, {3, 1},
    {1, 3}, {2, 0}, {3, 0}, {1, 4}, {9, 0}, {10, 0}, {11, 0}, {12, 0}, {13, 0}, {11, 1}, {12, 1}, {13, 1}, {1, 5}, {2, 1}, {3, 1}, {1, 6}};

__global__ void __launch_bounds__(512, 2) fwd_megakernel(Params p) {
    cg::grid_group grid = cg::this_grid();
    extern __shared__ __attribute__((aligned(16))) unsigned char lds_raw[];
    char* lds = (char*)lds_raw;
    LAS unsigned char* ldsl = (LAS unsigned char*)lds_raw;
    (void)p;
#define KP (*kparams())
    const int wv = __builtin_amdgcn_readfirstlane(threadIdx.x >> 6);
    volatile LAS unsigned* st = (volatile LAS unsigned*)(ldsl + 131072);
    { unsigned* bar0 = (unsigned*)(KP.ws + OFF_BAR); const unsigned xcc0 = xb_xcc_id();
      if (threadIdx.x == 0) { st[0] = 0u; st[1] = 0u; st[2] = 0u; st[3] = 0u; (void)xb_add(&bar0[XB_XCNT(xcc0)], 1u); } }
    __syncthreads();
#pragma clang loop unroll(disable)
    for (int pc = 0; pc < 29; ++pc) {
        const int op = __builtin_amdgcn_readfirstlane(PROG[pc][0]), arg = __builtin_amdgcn_readfirstlane(PROG[pc][1]);
        switch (op) {
        case 0: break;
        case 1: {
            const int s = arg, l = s / 3, i = s % 3;
            const int ip = s == 0 ? -1 : (s - 1) % 3, lp = s == 0 ? 0 : (s - 1) / 3;
            row_phase(KP, lp, ip, ip == 1 ? 1.0f : 0.5f, l, s == 6 ? -1 : i, s <= 1, wv, false);
        } break;
        case 2: ffn_in_phase(KP, arg == 0 ? WO_FI0 : WO_FI1, ldsl, wv); break;
        case 3: ffn_out_phase(KP, arg == 0 ? WO_FO0 : WO_FO1, ldsl, wv); break;
        case 4: gla_in_phase(KP, ldsl, wv); break;
        case 5: gla_gate_phase(KP, lds, wv); break;
        case 6: gla_scan_phase(KP, lds, wv); break;
        case 7: gla_post_phase(KP, wv); break;
        case 8: gla_out_phase(KP, ldsl, wv); break;
        case 9: mla_in_phase(KP, ldsl, wv); break;
        case 10: mla_row_phase(KP, wv); break;
        case 11: mla_proj_phase(KP, arg == 0 ? 0 : 12288, arg == 0 ? 12288 : 8192, arg == 0 ? 0 : 12800, arg == 0 ? 12800 : 8704, ldsl, wv); break;
        case 12: mla_attn_phase(KP, arg, lds, wv, false); break;
        default: mla_out_phase(KP, arg == 0 ? 0 : 12288, arg == 0 ? 12288 : 8192, ldsl, wv); break;
        }
        if (pc == 0 || pc == 12) mods_phase(KP, pc == 0 ? 0 : 1, lds, wv);
        {
            int cl = 0, cm = 0, cf = 0, cn = 1 << 20;
            if (pc == 0) { cl = 0; cm = 0x03; cf = 0; }
            else if (pc == 3) { cl = 0; cm = 0x3c; cf = 64; }
            else if (pc == 7) { cl = 1; cm = 0x03; cf = 0; cn = 128; }
            else if (pc == 12) { cl = 1; cm = 0xf4; cf = 64; }
            else if (pc == 13) { cl = 1; cm = 0x08; cf = 0; }
            if (cm) conv_phase(KP, cl, cm, cf, cn, lds, wv);
        }
        if (pc == 28) break;
        if (KP.out == nullptr) grid.sync();
        xcd_barrier((unsigned*)(KP.ws + OFF_BAR), st, wv);
    }
}

extern "C" void kernel_launch(void* const* d_in, const int* in_sizes, int n_in, void* d_out, int out_size, void* d_ws, size_t ws_size, hipStream_t stream) {
    static int grid_blocks = 0;
    if (!grid_blocks) {
        int dev = 0, cus = 0, per_cu = 0;
        (void)hipGetDevice(&dev);
        (void)hipDeviceGetAttribute(&cus, hipDeviceAttributeMultiprocessorCount, dev);
        if (hipFuncSetAttribute((const void*)fwd_megakernel, hipFuncAttributeMaxDynamicSharedMemorySize, LDS_BYTES) != hipSuccess) fprintf(stderr, "hipFuncSetAttribute failed\n");
        (void)hipOccupancyMaxActiveBlocksPerMultiprocessor(&per_cu, fwd_megakernel, NT, LDS_BYTES);
        if (per_cu > 1) per_cu = 1;
        if (per_cu < 1) per_cu = 1;
        grid_blocks = cus * per_cu;
        if (ws_size < WS_NEED) fprintf(stderr, "workspace too small: %zu < %zu\n", ws_size, (size_t)WS_NEED);
    }
    Params p{};
    const float** pp = (const float**)&p;
    for (int i = 0; i < 23; ++i) pp[i] = (const float*)d_in[i];
    p.out = (float*)d_out;
    p.ws = (char*)d_ws;
    (void)hipMemsetAsync((char*)d_ws + OFF_MODS, 0, SZ_MODS + SZ_BAR, stream);
    void* args[] = {&p};
    hipError_t e = hipLaunchCooperativeKernel((void*)fwd_megakernel, dim3(grid_blocks), dim3(NT), args, LDS_BYTES, stream);
    if (e != hipSuccess) fprintf(stderr, "cooperative launch failed: %s (grid %d)\n", hipGetErrorString(e), grid_blocks);
}
```

```cpp
#include <hip/hip_runtime.h>
#include <hip/hip_cooperative_groups.h>
#include <cstdint>
#include <cstdio>
namespace cg = cooperative_groups;
#ifndef PROBE
#define PROBE 0
#endif

typedef unsigned short bf16_t;
typedef short bf16x8 __attribute__((ext_vector_type(8)));
typedef float f32x4 __attribute__((ext_vector_type(4)));
typedef unsigned u32x4 __attribute__((ext_vector_type(4)));
typedef unsigned u32x2 __attribute__((ext_vector_type(2)));
#define LAS __attribute__((address_space(3)))

constexpr int NT = 512;
constexpr int D = 1024, T_CTX = 4096, T_LAT = 16384, T = 20480, DFF = 2816;
constexpr float EPS = 1e-6f;
constexpr int KV_ROWS = 21504;
constexpr size_t OUT_STATE = 20971520, OUT_CKV = 25165824, OUT_KR = 26214400;
constexpr int LDS_BYTES = 131072 + 16;

constexpr size_t OFF_MODS = 0;
constexpr size_t SZ_MODS = 2 * 5 * 9216 * 4;
constexpr size_t OFF_BAR = OFF_MODS + SZ_MODS;
constexpr size_t SZ_BAR = 16384;
constexpr size_t OFF_ROPE = OFF_BAR + SZ_BAR;
constexpr size_t OFF_W16 = OFF_ROPE + 8192;
constexpr size_t W_FFN_IN = (size_t)5632 * 1024 * 2, W_FFN_OUT = (size_t)1024 * 2816 * 2;
constexpr size_t WO_FI0 = 0, WO_FO0 = WO_FI0 + W_FFN_IN, WO_FI1 = WO_FO0 + W_FFN_OUT, WO_FO1 = WO_FI1 + W_FFN_IN, WO_MIX = WO_FO1 + W_FFN_OUT;
constexpr size_t WO_GLA_IN = WO_MIX, WO_GLA_OUT = WO_GLA_IN + (size_t)3328 * 1024 * 2;
constexpr size_t WO_MLA_IN = WO_MIX, WO_MLA_UQ = WO_MLA_IN + (size_t)1024 * 1024 * 2, WO_MLA_UKV = WO_MLA_UQ + (size_t)3072 * 512 * 2,
                 WO_MLA_OUT = WO_MLA_UKV + (size_t)4096 * 256 * 2;
constexpr size_t SZ_W16 = WO_MLA_OUT + (size_t)1024 * 2048 * 2;
constexpr size_t OFF_H = OFF_W16 + SZ_W16;
constexpr size_t SZ_H = (size_t)T * 1024 * 2;
constexpr size_t OFF_Y = OFF_H + SZ_H;
constexpr size_t SZ_Y = (size_t)T * 1024 * 4;
constexpr size_t OFF_BIG = OFF_Y + SZ_Y;
constexpr size_t OFF_ACT = OFF_BIG;
constexpr size_t OFF_QK = OFF_BIG;
constexpr size_t OFF_GVT = OFF_QK + SZ_H;
constexpr size_t OFF_R = OFF_GVT + SZ_H;
constexpr size_t OFF_KF = OFF_R + SZ_H;
constexpr size_t OFF_AF = OFF_KF + SZ_H;
constexpr size_t OFF_Z = OFF_AF + (size_t)2560 * 4096 * 2;
constexpr size_t OFF_DEC = OFF_Z + (size_t)T * 32 * 4;
constexpr size_t END_GLA = OFF_DEC + (size_t)2560 * 128 * 4;
constexpr size_t OFF_QF = OFF_H;
constexpr size_t OFF_OF = OFF_Y;
constexpr size_t OFF_PM = OFF_Y;
constexpr size_t OFF_CQN = OFF_H;
constexpr size_t OFF_CKV = OFF_CQN + (size_t)T * 512 * 2;
constexpr size_t OFF_KR = OFF_CKV + (size_t)KV_ROWS * 256 * 2;
constexpr size_t OFF_Q = OFF_BIG;
constexpr size_t OFF_KN = OFF_Q + (size_t)12288 * 3072 * 2;
constexpr size_t OFF_MVT = OFF_KN + (size_t)12800 * 2048 * 2;
constexpr size_t END_MLA = OFF_MVT + (size_t)12800 * 2048 * 2;
constexpr size_t WS_NEED = (END_GLA > END_MLA ? END_GLA : END_MLA);
static_assert(OFF_KR + (size_t)KV_ROWS * 64 * 2 <= OFF_Y, "mla small buffers overflow H region");
static_assert(OFF_ACT + (size_t)T * DFF * 2 <= WS_NEED, "act");
static_assert(WS_NEED <= 369098752, "workspace");

struct Params {
    const float *x_prompt, *x_sample, *state_gla, *cache_ckv, *cache_kr, *c, *c_ctx;
    const float *w_mod, *b_mod, *g_norm, *w_ffn_in, *w_ffn_out;
    const float *gla_w_in, *gla_w_gate, *gla_b_gate, *gla_g_out, *gla_w_out;
    const float *mla_w_in, *mla_g_q, *mla_g_kv, *mla_w_uq, *mla_w_ukv, *mla_w_out;
    float* out;
    char* ws;
};

typedef const __attribute__((address_space(4))) Params& PRef;

typedef float f32x2 __attribute__((ext_vector_type(2)));
typedef __bf16 bf16x2v __attribute__((ext_vector_type(2)));
__device__ __forceinline__ unsigned pk2(float a, float b) { f32x2 v = {a, b}; return __builtin_bit_cast(unsigned, __builtin_convertvector(v, bf16x2v)); }
__device__ __forceinline__ bf16_t f2bf(float a) { return (bf16_t)(pk2(a, 0.f) & 0xffffu); }
__device__ __forceinline__ float bf2f(bf16_t v) { return __uint_as_float(((unsigned)v) << 16); }
__device__ __forceinline__ float bflo(unsigned v) { return __uint_as_float(v << 16); }
__device__ __forceinline__ float bfhi(unsigned v) { return __uint_as_float(v & 0xffff0000u); }
__device__ __forceinline__ float wave_sum(float v) {
#pragma unroll
    for (int o = 32; o; o >>= 1) v += __shfl_xor(v, o);
    return v;
}
__device__ __forceinline__ float silu_f(float x) { return x * __builtin_amdgcn_rcpf(1.f + __builtin_amdgcn_exp2f(-1.4426950408889634f * x)); }
__device__ __forceinline__ f32x4 mfma16(bf16x8 a, bf16x8 b, f32x4 c) { return __builtin_amdgcn_mfma_f32_16x16x32_bf16(a, b, c, 0, 0, 0); }
__device__ __forceinline__ bf16x8 as_bf8(u32x4 v) { return __builtin_bit_cast(bf16x8, v); }
__device__ __forceinline__ int cond_of(int t) { return t < T_CTX ? 0 : 1 + ((t - T_CTX) >> 12); }
__device__ __forceinline__ int otid(int wv) { unsigned z = 0; asm volatile("" : "+v"(z)); int t = wv * 64 + (int)__builtin_amdgcn_mbcnt_hi(~0u, __builtin_amdgcn_mbcnt_lo(~0u, z)); asm volatile("" : "+v"(t)); return t; }
__device__ __forceinline__ u32x2 pk4(f32x4 v) { u32x2 o; o.x = pk2(v[0], v[1]); o.y = pk2(v[2], v[3]); return o; }

__device__ void mods_phase(PRef p, int layer, char* lds, int wv) {
    const int TIDX = otid(wv);
    const int tid = TIDX & 255, hf = TIDX >> 8;
    float* sc = (float*)lds + hf * 160;
    float* mods = (float*)(p.ws + OFF_MODS);
    for (int it = blockIdx.x; it < 9 * 32; it += gridDim.x) {
        const int l = layer, rem = it, nt = rem / 32, ks = (rem % 32) * 2 + hf;
        const int k0 = ks * 16;
        __syncthreads();
        if (tid < 160) {
            const int ci = tid >> 5, kk = tid & 31;
            const float cv = kk < 16 ? (ci == 0 ? p.c_ctx[k0 + kk] : p.c[(ci - 1) * 1024 + k0 + kk]) : 0.f;
            sc[tid] = silu_f(cv);
        }
        __syncthreads();
        const int n = nt * 1024 + tid * 4;
        f32x4 acc[5];
#pragma unroll
        for (int ci = 0; ci < 5; ++ci) acc[ci] = (f32x4){0.f, 0.f, 0.f, 0.f};
        const float* wp = p.w_mod + ((size_t)l * 1024 + k0) * 9216 + n;
#pragma unroll
        for (int kk = 0; kk < 16; ++kk) {
            const f32x4 w = *(const f32x4*)(wp + (size_t)kk * 9216);
#pragma unroll
            for (int ci = 0; ci < 5; ++ci) acc[ci] += w * sc[ci * 32 + kk];
        }
        if (ks == 0) {
            const f32x4 b = *(const f32x4*)(p.b_mod + l * 9216 + n);
#pragma unroll
            for (int ci = 0; ci < 5; ++ci) acc[ci] += b;
        }
#pragma unroll
        for (int ci = 0; ci < 5; ++ci)
#pragma unroll
            for (int j = 0; j < 4; ++j) atomicAdd(mods + ((size_t)l * 5 + ci) * 9216 + n + j, acc[ci][j]);
    }
    if (blockIdx.x == gridDim.x - 1 && layer == 0) {
        float* rt = (float*)(p.ws + OFF_ROPE);
        for (int i = TIDX; i < 1024; i += NT) {
            const int pos = i >> 4, f = i & 15;
            const float inv = exp2f(-(float)f * (13.287712379549449f / 16.f));
            const float x = (float)pos * inv;
            const float k = rintf(x * 0.15915494309189535f);
            float r = fmaf(-k, 6.28318548202514648f, x);
            r = fmaf(-k, -1.7484555e-7f, r);
            rt[i * 2] = __cosf(r);
            rt[i * 2 + 1] = __sinf(r);
        }
    }
}

__device__ void conv_matrix_tile(const float* __restrict__ src, bf16_t* __restrict__ dst, int K, int N, int perm, int kt, int nt, bool valid, bf16_t* tile, int tid) {
    __syncthreads();
    if (valid) {
        const int c4 = tid & 15, r0 = tid >> 4;
#pragma unroll
        for (int j = 0; j < 4; ++j) {
            const int r = r0 + 16 * j;
            const int n = nt * 64 + c4 * 4;
            f32x4 v = (f32x4){0.f, 0.f, 0.f, 0.f};
            if (n < N) v = *(const f32x4*)(src + (size_t)(kt * 64 + r) * N + n);
#pragma unroll
            for (int e = 0; e < 4; ++e) tile[(c4 * 4 + e) * 72 + r] = f2bf(v[e]);
        }
    }
    __syncthreads();
    if (valid) {
        const int c = tid >> 2, kc = tid & 3;
        const int n = nt * 64 + c;
        int np = n;
        if (perm == 1) np = n < DFF ? ((n >> 4) * 32 + (n & 15)) : (((n - DFF) >> 4) * 32 + 16 + ((n - DFF) & 15));
        else if (perm == 2) np = ((n & 255) < 128) ? ((n >> 8) * 128 + (n & 127)) : (2048 + (n >> 8) * 128 + (n & 127));
        const u32x4 v0 = *(const u32x4*)(tile + c * 72 + kc * 16);
        const u32x4 v1 = *(const u32x4*)(tile + c * 72 + kc * 16 + 8);
        bf16_t* d = dst + (size_t)np * K + kt * 64 + kc * 16;
        *(u32x4*)d = v0;
        *(u32x4*)(d + 8) = v1;
    }
}

__device__ void conv_phase(PRef p, int layer, int mask, int vfirst, int vcount, char* lds, int wv) {
    const int TIDX = otid(wv);
    char* w16 = p.ws + OFF_W16;
    const int tid = TIDX & 255, hf = TIDX >> 8;
    bf16_t* tile = (bf16_t*)(lds + hf * 9216);
    if ((int)blockIdx.x < vfirst || (int)blockIdx.x >= vfirst + vcount) return;
    const int vc = blockIdx.x - vfirst, vG = ((int)gridDim.x - vfirst) < vcount ? ((int)gridDim.x - vfirst) : vcount;
    for (int m = 0; m < 8; ++m) {
        if (!((mask >> m) & 1)) continue;
        const float* src; bf16_t* dst; int K, N, Np, perm = 0;
        if (m == 0)      { src = p.w_ffn_in + (size_t)(layer * 2 + 0) * 1024 * 5632; dst = (bf16_t*)(w16 + WO_FI0); K = 1024; N = 5632; Np = 5632; perm = 1; }
        else if (m == 1) { src = p.w_ffn_out + (size_t)(layer * 2 + 0) * 2816 * 1024; dst = (bf16_t*)(w16 + WO_FO0); K = 2816; N = 1024; Np = 1024; }
        else if (m == 2) { src = p.w_ffn_in + (size_t)(layer * 2 + 1) * 1024 * 5632; dst = (bf16_t*)(w16 + WO_FI1); K = 1024; N = 5632; Np = 5632; perm = 1; }
        else if (m == 3) { src = p.w_ffn_out + (size_t)(layer * 2 + 1) * 2816 * 1024; dst = (bf16_t*)(w16 + WO_FO1); K = 2816; N = 1024; Np = 1024; }
        else if (layer == 0) {
            if (m == 4)      { src = p.gla_w_in; dst = (bf16_t*)(w16 + WO_GLA_IN); K = 1024; N = 3104; Np = 3328; }
            else if (m == 5) { src = p.gla_w_out; dst = (bf16_t*)(w16 + WO_GLA_OUT); K = 1024; N = 1024; Np = 1024; }
            else break;
        } else {
            if (m == 4)      { src = p.mla_w_in; dst = (bf16_t*)(w16 + WO_MLA_IN); K = 1024; N = 832; Np = 1024; }
            else if (m == 5) { src = p.mla_w_uq; dst = (bf16_t*)(w16 + WO_MLA_UQ); K = 512; N = 3072; Np = 3072; }
            else if (m == 6) { src = p.mla_w_ukv; dst = (bf16_t*)(w16 + WO_MLA_UKV); K = 256; N = 4096; Np = 4096; perm = 2; }
            else             { src = p.mla_w_out; dst = (bf16_t*)(w16 + WO_MLA_OUT); K = 2048; N = 1024; Np = 1024; }
        }
        const int nkt = K / 64, nnt = Np / 64, ntiles = nkt * nnt;
        for (int t2 = vc; t2 * 2 < ntiles; t2 += vG) {
            const int t = t2 * 2 + hf;
            conv_matrix_tile(src, dst, K, N, perm, t / nnt, t % nnt, t < ntiles, tile, tid);
        }
    }
}

__device__ void row_phase(PRef p, int lprev, int iprev, float wprev, int lnext, int inext, bool first, int wv, bool dry) {
    const int TIDX = otid(wv);
    const int lane = TIDX & 63, w = TIDX >> 6;
    float* X = p.out;
    const bf16_t* Y = (const bf16_t*)(p.ws + OFF_Y);
    bf16_t* H = (bf16_t*)(p.ws + OFF_H);
    const float* mods = (const float*)(p.ws + OFF_MODS);
    for (int it = blockIdx.x; it < T / 40; it += gridDim.x) {
#pragma unroll
        for (int rr = 0; rr < 5; ++rr) {
            const int t = it * 40 + w * 5 + rr;
            const int ci = cond_of(t);
            const float* xs = first ? (t < T_CTX ? p.x_prompt + (size_t)t * D : p.x_sample + (size_t)(t - T_CTX) * D) : X + (size_t)t * D;
            f32x4 x[4];
#pragma unroll
            for (int j = 0; j < 4; ++j) x[j] = *(const f32x4*)(xs + j * 256 + lane * 4);
            if (iprev >= 0) {
                f32x4 y[4];
                float ss = 0.f;
#pragma unroll
                for (int j = 0; j < 4; ++j) { const u32x2 yb = *(const u32x2*)(Y + (size_t)t * D + j * 256 + lane * 4); y[j] = (f32x4){bflo(yb.x), bfhi(yb.x), bflo(yb.y), bfhi(yb.y)}; ss += y[j][0] * y[j][0] + y[j][1] * y[j][1] + y[j][2] * y[j][2] + y[j][3] * y[j][3]; }
                ss = wave_sum(ss);
                const float rs = rsqrtf(ss * (1.f / 1024.f) + EPS) * wprev;
                const float* gate = mods + ((size_t)lprev * 5 + ci) * 9216 + (3 * iprev + 2) * 1024;
                const float* gp = p.g_norm + ((size_t)(lprev * 3 + iprev) * 2 + 1) * 1024;
#pragma unroll
                for (int j = 0; j < 4; ++j) {
                    const f32x4 g = *(const f32x4*)(gate + j * 256 + lane * 4), gg = *(const f32x4*)(gp + j * 256 + lane * 4);
                    x[j] += g * (y[j] * gg) * rs;
                }
            }
            if (iprev >= 0 && !(dry && p.out != nullptr)) {
#pragma unroll
                for (int j = 0; j < 4; ++j) *(f32x4*)(X + (size_t)t * D + j * 256 + lane * 4) = x[j];
            }
            if (inext >= 0) {
                float ss = 0.f;
#pragma unroll
                for (int j = 0; j < 4; ++j) ss += x[j][0] * x[j][0] + x[j][1] * x[j][1] + x[j][2] * x[j][2] + x[j][3] * x[j][3];
                ss = wave_sum(ss);
                const float rs = rsqrtf(ss * (1.f / 1024.f) + EPS);
                const float* mb = mods + ((size_t)lnext * 5 + ci) * 9216 + (3 * inext) * 1024;
                const float* gp = p.g_norm + ((size_t)(lnext * 3 + inext) * 2 + 0) * 1024;
#pragma unroll
                for (int j = 0; j < 4; ++j) {
                    const int e = j * 256 + lane * 4;
                    const f32x4 sh = *(const f32x4*)(mb + e), scl = *(const f32x4*)(mb + 1024 + e), gg = *(const f32x4*)(gp + e);
                    const f32x4 h = (x[j] * rs) * gg * (scl + 1.f) + sh;
                    if (!(dry && p.out != nullptr)) *(u32x2*)(H + (size_t)t * D + e) = pk4(h);
                }
            }
        }
    }
}

namespace pg8 {
constexpr int BK = 64, HALF = 128, HTB = HALF * BK * 2;
__device__ __forceinline__ int lds_byte(int r, int c) { const int st = (r >> 4) * 2 + (c >> 5), rr = r & 15, cc = c & 31, ob = rr * 64 + cc * 2; return st * 1024 + (ob ^ (((ob >> 9) & 1) << 5)); }
__device__ __forceinline__ void stage_rc(int b, int& R, int& C) { const int st = b / 1024, sb = b % 1024, swz = sb ^ (((sb >> 9) & 1) << 5); R = (st >> 1) * 16 + swz / 64; C = (st & 1) * 32 + (swz % 64) / 2; }
struct Unit { const char* a; const char* b; int pm, pn, kind; };
__device__ __forceinline__ void tile_map(int wgid, int nM, int nN, int& pm, int& pn) {
    const int nwg = nM * nN;
    { const int q = nwg / 8, r = nwg % 8, xcd = wgid % 8, off = wgid / 8; wgid = (xcd < r ? xcd * (q + 1) : r * (q + 1) + (xcd - r) * q) + off; }
    const int nig = 8 * nN, gid = wgid / nig, fm = gid * 8, gsz = (nM - fm) < 8 ? (nM - fm) : 8;
    pm = fm + ((wgid % nig) % gsz); pn = (wgid % nig) / gsz;
}

template <int APAIR, class Epi, class Sched>
__device__ __forceinline__ void gemm_phase(LAS unsigned char* lds, int K, int lda, const Sched& S, const Epi& E, int wv) {
    const int TIDX = otid(wv);
    const int tid = TIDX, wid = __builtin_amdgcn_readfirstlane(tid >> 6), lane = tid & 63, wr = wid >> 2, wc = wid & 3, fr = lane & 15, fq = lane >> 4;
    const int nt = K / BK;
    unsigned voffA[2], voffB[2];
#pragma unroll
    for (int i = 0; i < 2; ++i) { int R, C; stage_rc(tid * 16 + i * 8192, R, C); voffA[i] = (unsigned)(R * lda + C) * 2u; voffB[i] = (unsigned)(R * K + C) * 2u; }
    const size_t kstep = (size_t)(BK * 2);
    const size_t hstepA = (size_t)HALF * lda * 2, hstepB = (size_t)HALF * K * 2;
    const unsigned ldsw = (unsigned)wid * 1024u;
    const int aoff = lds_byte(wr * 64 + fr, fq * 8), boff = lds_byte(wc * 32 + fr, fq * 8);
#define PG8_SA(b, h) (((b) * 2 + (h)) * HTB)
#define PG8_SB(b, h) ((4 + (b) * 2 + (h)) * HTB)
#define PG8_STAGE(bufoff, gbase, voff) do { _Pragma("unroll") for (int _i = 0; _i < 2; ++_i) \
        __builtin_amdgcn_global_load_lds((const unsigned*)((const char*)(gbase) + (voff)[_i]), (LAS unsigned*)(lds + (bufoff) + ldsw + _i * 8192), 16, 0, 0); } while (0)
#define PG8_LDA(dst, b, h) do { _Pragma("unroll") for (int m = 0; m < 4; ++m) _Pragma("unroll") for (int k = 0; k < 2; ++k) dst[m][k] = *(const LAS bf16x8*)(lds + PG8_SA(b, h) + aoff + m * 2048 + k * 1024); } while (0)
#define PG8_LDB(dst, b, h) do { _Pragma("unroll") for (int n = 0; n < 2; ++n) _Pragma("unroll") for (int k = 0; k < 2; ++k) dst[n][k] = *(const LAS bf16x8*)(lds + PG8_SB(b, h) + boff + n * 2048 + k * 1024); } while (0)
#define PG8_MMA(ai, bj, At, Bt) do { __builtin_amdgcn_s_setprio(1); _Pragma("unroll") for (int m = 0; m < 4; ++m) _Pragma("unroll") for (int n = 0; n < 2; ++n) _Pragma("unroll") for (int k = 0; k < 2; ++k) \
        acc[ai][bj][m][n] = __builtin_amdgcn_mfma_f32_16x16x32_bf16(Bt[n][k], At[m][k], acc[ai][bj][m][n], 0, 0, 0); __builtin_amdgcn_s_setprio(0); } while (0)
#define PG8_WAIT_V(n) asm volatile("s_waitcnt vmcnt(" #n ")" ::: "memory")
#define PG8_WAIT_L(n) asm volatile("s_waitcnt lgkmcnt(" #n ")" ::: "memory")
#define PG8_BAR __builtin_amdgcn_s_barrier()
#define PG8_SCHED __builtin_amdgcn_sched_barrier(0)
    Unit cur, nxt; int ui = 0;
    if (!S.next(0, cur)) return;
    f32x4 acc[2][2][4][2];
#pragma unroll
    for (int a = 0; a < 2; ++a)
#pragma unroll
        for (int b = 0; b < 2; ++b)
#pragma unroll
            for (int m = 0; m < 4; ++m)
#pragma unroll
                for (int n = 0; n < 2; ++n) acc[a][b][m][n] = (f32x4){0.f, 0.f, 0.f, 0.f};
    bf16x8 At[4][2], B0[2][2], B1[2][2];
    const char* cA = cur.a; const char* cB = cur.b;
    PG8_STAGE(PG8_SB(0, 0), cB, voffB); PG8_STAGE(PG8_SB(0, 1), cB + hstepB, voffB); PG8_STAGE(PG8_SA(0, 0), cA, voffA); PG8_STAGE(PG8_SA(0, 1), cA + hstepA, voffA);
    if (wr == 1) PG8_BAR;
    PG8_WAIT_V(2); PG8_BAR;
    PG8_STAGE(PG8_SB(1, 0), cB + kstep, voffB); PG8_STAGE(PG8_SA(1, 0), cA + kstep, voffA); PG8_STAGE(PG8_SB(1, 1), cB + hstepB + kstep, voffB);
    PG8_WAIT_V(6); PG8_BAR;
    for (;;) {
        const bool has_next = S.next(ui + 1, nxt);
        const char* nA = has_next ? nxt.a : cA; const char* nB = has_next ? nxt.b : cB;
        for (int t = 0; t < nt; t += 2) {
            const bool last = (t == nt - 2);
            const char* a1 = cA + (size_t)(t >> 1) * APAIR + kstep;
            const char* a2 = last ? nA : cA + (size_t)((t >> 1) + 1) * APAIR; const char* b2 = last ? nB : cB + (size_t)(t + 2) * kstep;
            const char* a3 = a2 + kstep; const char* b3 = b2 + kstep;
            PG8_LDB(B0, 0, 0); PG8_LDB(B1, 0, 1); PG8_SCHED; PG8_LDA(At, 0, 0); PG8_STAGE(PG8_SA(1, 1), a1 + hstepA, voffA);
            PG8_WAIT_V(8); PG8_WAIT_L(0); PG8_BAR; PG8_MMA(0, 0, At, B0); PG8_MMA(0, 1, At, B1); PG8_BAR; PG8_SCHED;
            PG8_LDA(At, 0, 1); PG8_STAGE(PG8_SB(0, 0), b2, voffB); PG8_STAGE(PG8_SB(0, 1), b2 + hstepB, voffB); PG8_STAGE(PG8_SA(0, 0), a2, voffA);
            PG8_WAIT_V(8); PG8_WAIT_L(0); PG8_BAR; PG8_MMA(1, 0, At, B0); PG8_MMA(1, 1, At, B1); PG8_BAR; PG8_SCHED;
            PG8_LDB(B0, 1, 0); PG8_LDB(B1, 1, 1); PG8_SCHED; PG8_LDA(At, 1, 0); PG8_STAGE(PG8_SA(0, 1), a2 + hstepA, voffA);
            PG8_WAIT_V(8); PG8_WAIT_L(0); PG8_BAR; PG8_MMA(0, 0, At, B0); PG8_MMA(0, 1, At, B1); PG8_BAR; PG8_SCHED;
            PG8_LDA(At, 1, 1); PG8_STAGE(PG8_SB(1, 0), b3, voffB); PG8_STAGE(PG8_SB(1, 1), b3 + hstepB, voffB); PG8_STAGE(PG8_SA(1, 0), a3, voffA);
            PG8_WAIT_V(8); PG8_WAIT_L(0); PG8_BAR; PG8_MMA(1, 0, At, B0); PG8_MMA(1, 1, At, B1); PG8_BAR; PG8_SCHED;
        }
        if (wr == 0) PG8_BAR;
        { const int ln2 = otid(0);
          E(acc, cur, wr, wc, ln2 & 15, ln2 >> 4); }
        if (!has_next) break;
#pragma unroll
        for (int a = 0; a < 2; ++a)
#pragma unroll
            for (int b = 0; b < 2; ++b)
#pragma unroll
                for (int m = 0; m < 4; ++m)
#pragma unroll
                    for (int n = 0; n < 2; ++n) acc[a][b][m][n] = (f32x4){0.f, 0.f, 0.f, 0.f};
        cur = nxt; cA = nA; cB = nB; ++ui;
        if (wr == 1) PG8_BAR;
    }
    PG8_WAIT_V(0);
    PG8_BAR;
#undef PG8_SA
#undef PG8_SB
#undef PG8_STAGE
#undef PG8_LDA
#undef PG8_LDB
#undef PG8_MMA
#undef PG8_WAIT_V
#undef PG8_WAIT_L
#undef PG8_BAR
#undef PG8_SCHED
}
}
using pg8::Unit;
typedef f32x4 Acc[2][2][4][2];

struct Sched3 {
    int n0, nM0, nN0, n1, nM1, nN1;
    const char *a0, *b0, *a1, *b1;
    size_t ta, tb;
    int c, G;
    int bskip_from, bskip_by;
    __device__ __forceinline__ bool next(int i, Unit& u) const {
        int L = i * G + c;
        int k, nm, nn; const char* ab; const char* bb;
        if (L < n0) { k = 0; nm = nM0; nn = nN0; ab = a0; bb = b0; }
        else { L -= n0; if (L >= n1) return false; k = 1; nm = nM1; nn = nN1; ab = a1; bb = b1; }
        int pm, pn; pg8::tile_map(L, nm, nn, pm, pn);
        if (k == 0 && pn >= bskip_from) pn += bskip_by;
        u.pm = pm; u.pn = pn; u.kind = k;
        u.a = ab + (size_t)pm * ta; u.b = bb + (size_t)pn * tb;
        return true;
    }
};
__device__ __forceinline__ Sched3 make_sched(int c, int G, size_t ta, size_t tb) {
    Sched3 s; s.n0 = 0; s.nM0 = 1; s.nN0 = 1; s.n1 = 0; s.nM1 = 1; s.nN1 = 1; s.a0 = nullptr; s.b0 = nullptr; s.a1 = nullptr; s.b1 = nullptr;
    s.ta = ta; s.tb = tb; s.c = c; s.G = G; s.bskip_from = 1 << 30; s.bskip_by = 0; return s;
}

struct EpiFfnIn {
    bf16_t* act;
    __device__ __forceinline__ void operator()(Acc& acc, const Unit& u, int wr, int wc, int fr, int fq) const {
#pragma unroll
        for (int ai = 0; ai < 2; ++ai)
#pragma unroll
            for (int m = 0; m < 4; ++m) {
                bf16_t* rp = act + (size_t)(u.pm * 256 + ai * 128 + wr * 64 + m * 16 + fr) * DFF + u.pn * 128 + wc * 16 + fq * 4;
#pragma unroll
                for (int bj = 0; bj < 2; ++bj) {
                    const f32x4 g = acc[ai][bj][m][0], uu = acc[ai][bj][m][1];
                    u32x2 o; o.x = pk2(silu_f(g[0]) * uu[0], silu_f(g[1]) * uu[1]); o.y = pk2(silu_f(g[2]) * uu[2], silu_f(g[3]) * uu[3]);
                    *(u32x2*)(rp + bj * 64) = o;
                }
            }
    }
};
struct EpiF32 {
    float* C; int ldc; int ncols;
    __device__ __forceinline__ void operator()(Acc& acc, const Unit& u, int wr, int wc, int fr, int fq) const {
#pragma unroll
        for (int ai = 0; ai < 2; ++ai)
#pragma unroll
            for (int m = 0; m < 4; ++m) {
                float* rp = C + (size_t)(u.pm * 256 + ai * 128 + wr * 64 + m * 16 + fr) * ldc;
#pragma unroll
                for (int bj = 0; bj < 2; ++bj)
#pragma unroll
                    for (int n = 0; n < 2; ++n) {
                        const int col = u.pn * 256 + bj * 128 + wc * 32 + n * 16 + fq * 4;
                        if (col < ncols) *(f32x4*)(rp + col) = acc[ai][bj][m][n];
                    }
            }
    }
};
struct EpiBf16Y {
    bf16_t* C;
    __device__ __forceinline__ void operator()(Acc& acc, const Unit& u, int wr, int wc, int fr, int fq) const {
#pragma unroll
        for (int ai = 0; ai < 2; ++ai)
#pragma unroll
            for (int m = 0; m < 4; ++m) {
                bf16_t* rp = C + (size_t)(u.pm * 256 + ai * 128 + wr * 64 + m * 16 + fr) * 1024 + u.pn * 256 + wc * 32 + fq * 4;
#pragma unroll
                for (int bj = 0; bj < 2; ++bj)
#pragma unroll
                    for (int n = 0; n < 2; ++n) *(u32x2*)(rp + bj * 128 + n * 16) = pk4(acc[ai][bj][m][n]);
            }
    }
};
struct EpiGlaIn {
    bf16_t* qk; bf16_t* r; float* z; bf16_t* vt;
    __device__ __forceinline__ void operator()(Acc& acc, const Unit& u, int wr, int wc, int fr, int fq) const {
        if (u.kind == 0) {
#pragma unroll
            for (int ai = 0; ai < 2; ++ai)
#pragma unroll
                for (int m = 0; m < 4; ++m) {
                    const size_t row = u.pm * 256 + ai * 128 + wr * 64 + m * 16 + fr;
#pragma unroll
                    for (int bj = 0; bj < 2; ++bj)
#pragma unroll
                        for (int n = 0; n < 2; ++n) {
                            const int col = u.pn * 256 + bj * 128 + wc * 32 + n * 16 + fq * 4;
                            const f32x4 v = acc[ai][bj][m][n];
                            if (col < 1024) *(u32x2*)(qk + row * 1024 + col) = pk4(v);
                            else if (col >= 2048 && col < 3072) *(u32x2*)(r + row * 1024 + (col - 2048)) = pk4(v);
                            else if (col >= 3072 && col < 3104) *(f32x4*)(z + row * 32 + (col - 3072)) = v;
                        }
                }
        } else {
            bf16_t* base = vt + (size_t)(u.pn * 4 + (wc >> 1)) * 65536 + u.pm * 16384 + (wr * 4) * 1024 + (wc & 1) * 512 + (fq * 16 + fr) * 8;
#pragma unroll
            for (int ai = 0; ai < 2; ++ai)
#pragma unroll
                for (int m = 0; m < 4; ++m)
#pragma unroll
                    for (int bj = 0; bj < 2; ++bj)
#pragma unroll
                        for (int n = 0; n < 2; ++n) *(u32x2*)(base + bj * 131072 + (ai * 8 + m) * 1024 + n * 4) = pk4(acc[ai][bj][m][n]);
        }
    }
};
struct EpiMlaQ {
    bf16_t* q; int row0; const float* rope;
    __device__ __forceinline__ void operator()(Acc& acc, const Unit& u, int wr, int wc, int fr, int fq) const {
        const float qs = 0.07216878364870323f * 1.4426950408889634f;
#pragma unroll
        for (int bj = 0; bj < 2; ++bj) {
            const int c0 = u.pn * 256 + bj * 128 + wc * 32;
            const int sec = c0 % 192;
#pragma unroll
            for (int ai = 0; ai < 2; ++ai)
#pragma unroll
                for (int m = 0; m < 4; ++m) {
                    const int lrow = u.pm * 256 + ai * 128 + wr * 64 + m * 16 + fr;
                    const int t = row0 + lrow;
                    f32x4 v0 = acc[ai][bj][m][0], v1 = acc[ai][bj][m][1];
                    if (sec >= 128 && t >= T_CTX) {
                        const int s = (t - T_CTX) & 4095;
                        const int pos = sec == 128 ? (s >> 6) : (s & 63);
#pragma unroll
                        for (int j = 0; j < 4; ++j) {
                            const float cs = rope[(pos * 16 + fq * 4 + j) * 2], sn = rope[(pos * 16 + fq * 4 + j) * 2 + 1];
                            const float a1 = v0[j], a2 = v1[j];
                            v0[j] = a1 * cs - a2 * sn; v1[j] = a2 * cs + a1 * sn;
                        }
                    }
                    bf16_t* rp = q + (size_t)lrow * 3072 + c0 + fq * 4;
                    *(u32x2*)(rp) = pk4(v0 * qs);
                    *(u32x2*)(rp + 16) = pk4(v1 * qs);
                }
        }
    }
};
struct EpiMlaKv {
    bf16_t* kn; bf16_t* vt;
    __device__ __forceinline__ void operator()(Acc& acc, const Unit& u, int wr, int wc, int fr, int fq) const {
        if (u.kind == 0) {
            bf16_t* base = kn + (size_t)(u.pm * 256 + wr * 64 + fr) * 2048 + u.pn * 256 + wc * 32 + fq * 4;
#pragma unroll
            for (int ai = 0; ai < 2; ++ai)
#pragma unroll
                for (int m = 0; m < 4; ++m)
#pragma unroll
                    for (int bj = 0; bj < 2; ++bj)
#pragma unroll
                        for (int n = 0; n < 2; ++n) *(u32x2*)(base + (ai * 128 + m * 16) * 2048 + bj * 128 + n * 16) = pk4(acc[ai][bj][m][n]);
        } else {
            bf16_t* base = vt + (size_t)(u.pn * 4 + (wc >> 1)) * 131072 + (u.pm * 2) * 8192 + (wr * 4) * 1024 + (wc & 1) * 512 + (fq * 16 + fr) * 8;
#pragma unroll
            for (int ai = 0; ai < 2; ++ai)
#pragma unroll
                for (int m = 0; m < 4; ++m)
#pragma unroll
                    for (int bj = 0; bj < 2; ++bj)
#pragma unroll
                        for (int n = 0; n < 2; ++n) *(u32x2*)(base + bj * 262144 + ai * 8192 + m * 1024 + n * 4) = pk4(acc[ai][bj][m][n]);
        }
    }
};

__device__ void ffn_in_phase(PRef p, size_t woff, LAS unsigned char* lds, int wv) {
    Sched3 s = make_sched(blockIdx.x, gridDim.x, (size_t)256 * 1024 * 2, (size_t)256 * 1024 * 2);
    s.n0 = 80 * 22; s.nM0 = 80; s.nN0 = 22; s.a0 = p.ws + OFF_H; s.b0 = p.ws + OFF_W16 + woff;
    EpiFfnIn epi{(bf16_t*)(p.ws + OFF_ACT)};
    pg8::gemm_phase<256>(lds, 1024, 1024, s, epi, wv);
}
__device__ void ffn_out_phase(PRef p, size_t woff, LAS unsigned char* lds, int wv) {
    Sched3 s = make_sched(blockIdx.x, gridDim.x, (size_t)256 * DFF * 2, (size_t)256 * DFF * 2);
    s.n0 = 80 * 4; s.nM0 = 80; s.nN0 = 4; s.a0 = p.ws + OFF_ACT; s.b0 = p.ws + OFF_W16 + woff;
    EpiBf16Y epi{(bf16_t*)(p.ws + OFF_Y)};
    pg8::gemm_phase<256>(lds, DFF, DFF, s, epi, wv);
}
__device__ void gla_in_phase(PRef p, LAS unsigned char* lds, int wv) {
    Sched3 s = make_sched(blockIdx.x, gridDim.x, (size_t)256 * 1024 * 2, (size_t)256 * 1024 * 2);
    s.n0 = 80 * 9; s.nM0 = 80; s.nN0 = 9; s.a0 = p.ws + OFF_H; s.b0 = p.ws + OFF_W16 + WO_GLA_IN; s.bskip_from = 4; s.bskip_by = 4;
    s.n1 = 4 * 80; s.nM1 = 4; s.nN1 = 80; s.a1 = p.ws + OFF_W16 + WO_GLA_IN + (size_t)1024 * 1024 * 2; s.b1 = p.ws + OFF_H;
    EpiGlaIn epi{(bf16_t*)(p.ws + OFF_QK), (bf16_t*)(p.ws + OFF_R), (float*)(p.ws + OFF_Z), (bf16_t*)(p.ws + OFF_GVT)};
    pg8::gemm_phase<256>(lds, 1024, 1024, s, epi, wv);
}
__device__ void gla_out_phase(PRef p, LAS unsigned char* lds, int wv) {
    Sched3 s = make_sched(blockIdx.x, gridDim.x, (size_t)256 * 1024 * 2, (size_t)256 * 1024 * 2);
    s.n0 = 80 * 4; s.nM0 = 80; s.nN0 = 4; s.a0 = p.ws + OFF_QK; s.b0 = p.ws + OFF_W16 + WO_GLA_OUT;
    EpiBf16Y epi{(bf16_t*)(p.ws + OFF_Y)};
    pg8::gemm_phase<256>(lds, 1024, 1024, s, epi, wv);
}
__device__ void mla_in_phase(PRef p, LAS unsigned char* lds, int wv) {
    Sched3 s = make_sched(blockIdx.x, gridDim.x, (size_t)256 * 1024 * 2, (size_t)256 * 1024 * 2);
    s.n0 = 80 * 4; s.nM0 = 80; s.nN0 = 4; s.a0 = p.ws + OFF_H; s.b0 = p.ws + OFF_W16 + WO_MLA_IN;
    EpiF32 epi{(float*)(p.ws + OFF_PM), 832, 832};
    pg8::gemm_phase<256>(lds, 1024, 1024, s, epi, wv);
}
__device__ void mla_proj_phase(PRef p, int q0, int nq, int k0, int nkv, LAS unsigned char* lds, int wv) {
    {
        Sched3 s = make_sched(blockIdx.x, gridDim.x, (size_t)256 * 512 * 2, (size_t)256 * 512 * 2);
        s.n0 = (nq / 256) * 12; s.nM0 = nq / 256; s.nN0 = 12; s.a0 = p.ws + OFF_CQN + (size_t)q0 * 512 * 2; s.b0 = p.ws + OFF_W16 + WO_MLA_UQ;
        EpiMlaQ epi{(bf16_t*)(p.ws + OFF_Q), q0, (const float*)(p.ws + OFF_ROPE)};
        pg8::gemm_phase<256>(lds, 512, 512, s, epi, wv);
    }
    {
        Sched3 s = make_sched(gridDim.x - 1 - blockIdx.x, gridDim.x, (size_t)256 * 256 * 2, (size_t)256 * 256 * 2);
        const char* ckv = p.ws + OFF_CKV + (size_t)k0 * 256 * 2;
        const char* w = p.ws + OFF_W16 + WO_MLA_UKV;
        s.n0 = (nkv / 256) * 8; s.nM0 = nkv / 256; s.nN0 = 8; s.a0 = ckv; s.b0 = w;
        s.n1 = 8 * (nkv / 256); s.nM1 = 8; s.nN1 = nkv / 256; s.a1 = w + (size_t)2048 * 256 * 2; s.b1 = ckv;
        EpiMlaKv epi{(bf16_t*)(p.ws + OFF_KN), (bf16_t*)(p.ws + OFF_MVT)};
        pg8::gemm_phase<256>(lds, 256, 256, s, epi, wv);
    }
}
__device__ void mla_out_phase(PRef p, int q0, int nq, LAS unsigned char* lds, int wv) {
    Sched3 s = make_sched(blockIdx.x, gridDim.x, (size_t)256 * 3072 * 2, (size_t)256 * 2048 * 2);
    s.n0 = (nq / 256) * 4; s.nM0 = nq / 256; s.nN0 = 4; s.a0 = p.ws + OFF_Q; s.b0 = p.ws + OFF_W16 + WO_MLA_OUT;
    EpiBf16Y epi{(bf16_t*)(p.ws + OFF_Y) + (size_t)q0 * 1024};
    pg8::gemm_phase<384>(lds, 2048, 3072, s, epi, wv);
}

__device__ __forceinline__ float gla_logdecay(float logit) {
    return (fminf(logit, 0.f) - __logf(1.f + __expf(-fabsf(logit)))) * (1.f / 16.f);
}

#define GATE_BAR() do { asm volatile("s_waitcnt lgkmcnt(0)" ::: "memory"); __builtin_amdgcn_s_barrier(); asm volatile("" ::: "memory"); } while (0)
__device__ void gla_gate_phase(PRef p, char* lds0, int wv) {
    const int TIDX = otid(wv);
    const int hw = TIDX >> 8, tid = TIDX & 255;
    char* lds = lds0 + hw * 57344;
    float* zs = (float*)lds;
    float* tot = (float*)(lds + 4096);
    bf16_t* QFl = (bf16_t*)(lds + 8192);
    bf16_t* KFl = (bf16_t*)(lds + 8192 + 16384);
    bf16_t* KQl = (bf16_t*)(lds + 8192 + 32768);
    const int lane = tid & 63, w = tid >> 6, l15 = lane & 15, quad = lane >> 4;
    const int dk = tid & 127, hf = tid >> 7;
    const bf16_t* QK = (const bf16_t*)(p.ws + OFF_QK);
    const float* Z = (const float*)(p.ws + OFF_Z);
    bf16_t* QF = (bf16_t*)(p.ws + OFF_QF);
    bf16_t* KF = (bf16_t*)(p.ws + OFF_KF);
    bf16_t* AF = (bf16_t*)(p.ws + OFF_AF);
    float* DEC = (float*)(p.ws + OFF_DEC);
    for (int it2 = blockIdx.x; it2 < 1280; it2 += gridDim.x) {
        const int it = it2 * 2 + hw;
        const int dir = it & 1, head = (it >> 1) & 3, gch = it >> 3;
        GATE_BAR();
        {
            const int tok = tid >> 2, r4 = (tid & 3) * 4;
            *(f32x4*)(zs + tok * 16 + r4) = *(const f32x4*)(Z + (size_t)(gch * 64 + tok) * 32 + dir * 16 + r4);
        }
        {
#pragma unroll
            for (int j = 0; j < 8; ++j) {
                const int ci = tid + 256 * j;
                const int isk = ci >> 10, tok = (ci >> 4) & 63, ch = ci & 15, dk0 = ch * 8;
                const u32x4 v = *(const u32x4*)(QK + (size_t)(gch * 64 + tok) * 1024 + isk * 512 + head * 128 + dk0);
                bf16_t* dst = isk ? KQl : QFl;
                const int base = ((((tok >> 4) * 4 + (dk0 >> 5)) * 64 + (tok & 15)) << 3) + ((dk0 >> 4) & 1) * 4;
                const int q0 = (dk0 & 15) >> 2;
                u32x2 lo, hi; lo.x = v.x; lo.y = v.y; hi.x = v.z; hi.y = v.w;
                *(u32x2*)(dst + base + ((q0 * 16) << 3)) = lo;
                *(u32x2*)(dst + base + (((q0 + 1) * 16) << 3)) = hi;
            }
        }
        float wg[16];
#pragma unroll
        for (int r = 0; r < 16; ++r) wg[r] = p.gla_w_gate[((size_t)dir * 16 + r) * 512 + head * 128 + dk];
        const float bg = p.gla_b_gate[dir * 512 + head * 128 + dk];
        GATE_BAR();
        float sum = 0.f;
        float gv[32];
#pragma unroll
        for (int s2 = 0; s2 < 32; ++s2) {
            const int s = hf * 32 + s2;
            const int tok = dir ? 63 - s : s;
            float lg = bg;
#pragma unroll
            for (int r = 0; r < 16; ++r) lg = fmaf(zs[tok * 16 + r], wg[r], lg);
            gv[s2] = gla_logdecay(lg);
            sum += gv[s2];
        }
        tot[hf * 128 + dk] = sum;
        GATE_BAR();
        float run = hf ? tot[dk] : 0.f;
        if (hf == 0) DEC[(size_t)it * 128 + dk] = __expf(tot[dk] + tot[128 + dk]);
#pragma unroll
        for (int s2 = 0; s2 < 32; ++s2) {
            const int s = hf * 32 + s2;
            const int tok = dir ? 63 - s : s;
            run += gv[s2];
            const int qi = ((((tok >> 4) * 4 + (dk >> 5)) * 64 + ((dk & 15) >> 2) * 16 + (tok & 15)) << 3) + ((dk >> 4) & 1) * 4 + (dk & 3);
            const float qv = bf2f(QFl[qi]) * 0.08838834764831845f * __expf(run);
            const float kv = bf2f(KQl[qi]) * __expf(-run);
            const int ki = ((((dk >> 4) * 2 + (tok >> 5)) * 64 + ((tok & 15) >> 2) * 16 + (dk & 15)) << 3) + ((tok >> 4) & 1) * 4 + (tok & 3);
            const bf16_t kb = f2bf(kv);
            QFl[qi] = f2bf(qv);
            KQl[qi] = kb;
            KFl[ki] = kb;
        }
        GATE_BAR();
        {
            f32x4 s[4];
#pragma unroll
            for (int mb = 0; mb < 4; ++mb) s[mb] = (f32x4){0.f, 0.f, 0.f, 0.f};
#pragma unroll
            for (int ks = 0; ks < 4; ++ks) {
                const bf16x8 qf = *(const bf16x8*)(QFl + ((w * 4 + ks) * 64 + lane) * 8);
#pragma unroll
                for (int mb = 0; mb < 4; ++mb) {
                    const bf16x8 kf = *(const bf16x8*)(KQl + ((mb * 4 + ks) * 64 + lane) * 8);
                    s[mb] = mfma16(kf, qf, s[mb]);
                }
            }
            const int i = w * 16 + l15;
#pragma unroll
            for (int mb = 0; mb < 4; ++mb)
#pragma unroll
                for (int r = 0; r < 4; ++r) {
                    const int j = mb * 16 + quad * 4 + r;
                    const bool keep = dir ? (j >= i) : (j <= i);
                    if (!keep) s[mb][r] = 0.f;
                }
#pragma unroll
            for (int pp = 0; pp < 2; ++pp) {
                u32x4 o;
                o.x = pk2(s[2 * pp][0], s[2 * pp][1]); o.y = pk2(s[2 * pp][2], s[2 * pp][3]);
                o.z = pk2(s[2 * pp + 1][0], s[2 * pp + 1][1]); o.w = pk2(s[2 * pp + 1][2], s[2 * pp + 1][3]);
                *(u32x4*)(AF + (size_t)it * 4096 + ((w * 2 + pp) * 64 + lane) * 8) = o;
            }
        }
#pragma unroll
        for (int j = 0; j < 4; ++j) {
            const int ci = tid + 256 * j;
            *(u32x4*)(QF + (size_t)it * 8192 + ci * 8) = *(const u32x4*)(QFl + ci * 8);
            *(u32x4*)(KF + (size_t)it * 8192 + ci * 8) = *(const u32x4*)(KFl + ci * 8);
        }
    }
}

#define LDS_BARRIER_() do { asm volatile("s_waitcnt lgkmcnt(0)" ::: "memory"); __builtin_amdgcn_s_barrier(); asm volatile("" ::: "memory"); } while (0)
__device__ void gla_scan_phase(PRef p, char* lds0, int wv) {
    const int TIDX = otid(wv);
    const int hw = TIDX >> 8, tid = TIDX & 255;
    char* lds = lds0 + hw * 41472;
    bf16_t* KFl = (bf16_t*)lds;
    bf16_t* VFl = (bf16_t*)(lds + 16384);
    bf16_t* HB = (bf16_t*)(lds + 24576);
    float* DCl = (float*)(lds + 40960);
    const int lane = tid & 63, w = tid >> 6, l15 = lane & 15, quad = lane >> 4;
    bf16_t* OSl = (bf16_t*)(lds0 + 82944 + (TIDX >> 6) * 2304);
    const bf16_t* QF = (const bf16_t*)(p.ws + OFF_QF);
    const bf16_t* KF = (const bf16_t*)(p.ws + OFF_KF);
    const bf16_t* AF = (const bf16_t*)(p.ws + OFF_AF);
    const bf16_t* VT = (const bf16_t*)(p.ws + OFF_GVT);
    const float* DEC = (const float*)(p.ws + OFF_DEC);
    bf16_t* OF = (bf16_t*)(p.ws + OFF_OF);
    for (int vrt = blockIdx.x; vrt < 512; vrt += gridDim.x) {
        const int vb = vrt & 255, rnd = vrt >> 8;
        if (rnd == 1 && vb >= 128) continue;
        int b, rem, nch, gch0, dir; bool active; const bool lat = vb >= 128;
        if (lat) { const int c = vb - 128, xcd = c & 7, slot = c >> 3, pair = xcd * 2 + (slot >> 3), within = slot & 7;
                   b = pair >> 2; rem = ((pair & 3) << 2) | (within & 3); dir = within >> 2; nch = 64; gch0 = 64 + b * 64; active = hw == 0; }
        else { const int u = rnd * 128 + vb; b = u >> 4; rem = u & 15; dir = hw; nch = 4; gch0 = b * 4; active = true; }
        const int head = rem >> 2, s4 = rem & 3;
        if (!active) {
            __syncthreads();
            for (int s = 0; s < nch; ++s) { LDS_BARRIER_(); LDS_BARRIER_(); }
            continue;
        }
        f32x4 st[8];
        if (lat) {
            const float* sp = p.state_gla + (((size_t)b * 2 + dir) * 4 + head) * 32768 + s4 * 64 + w * 16 + l15;
#pragma unroll
            for (int mb = 0; mb < 8; ++mb)
#pragma unroll
                for (int r = 0; r < 4; ++r) st[mb][r] = sp[(size_t)(mb * 16 + quad * 4 + r) * 256];
        } else {
#pragma unroll
            for (int mb = 0; mb < 8; ++mb) st[mb] = (f32x4){0.f, 0.f, 0.f, 0.f};
        }
        __syncthreads();
#pragma unroll
        for (int ks = 0; ks < 4; ++ks) {
            u32x4 o;
            o.x = pk2(st[2 * ks][0], st[2 * ks][1]); o.y = pk2(st[2 * ks][2], st[2 * ks][3]);
            o.z = pk2(st[2 * ks + 1][0], st[2 * ks + 1][1]); o.w = pk2(st[2 * ks + 1][2], st[2 * ks + 1][3]);
            *(u32x4*)(HB + ((w * 4 + ks) * 64 + lane) * 8) = o;
        }
        u32x4 rK0[4], rV0[2], rQ0[4], rA0[2]; f32x4 rD0;
#define SCAN_LOAD(step, rK, rV, rQ, rA, rD) { const int c_ = dir ? nch - 1 - (step) : (step); const size_t gi_ = ((size_t)(gch0 + c_) * 4 + head) * 2 + dir; \
    _Pragma("unroll") for (int j = 0; j < 4; ++j) rK[j] = *(const u32x4*)(KF + gi_ * 8192 + (tid + 256 * j) * 8); \
    _Pragma("unroll") for (int j = 0; j < 2; ++j) rV[j] = *(const u32x4*)(VT + ((size_t)(gch0 + c_) * 4 + head) * 16384 + s4 * 4096 + (tid + 256 * j) * 8); \
    _Pragma("unroll") for (int j = 0; j < 4; ++j) rQ[j] = *(const u32x4*)(QF + gi_ * 8192 + ((w * 4 + j) * 64 + lane) * 8); \
    _Pragma("unroll") for (int j = 0; j < 2; ++j) rA[j] = *(const u32x4*)(AF + gi_ * 4096 + ((w * 2 + j) * 64 + lane) * 8); \
    if (tid < 32) rD = *(const f32x4*)(DEC + gi_ * 128 + tid * 4); }
#define LDS_BARRIER() do { asm volatile("s_waitcnt lgkmcnt(0)" ::: "memory"); __builtin_amdgcn_s_barrier(); asm volatile("" ::: "memory"); } while (0)
#define SCAN_STEP(s, rK, rV, rQ, rA, rD) { \
            const int c = dir ? nch - 1 - (s) : (s); \
            _Pragma("unroll") for (int j = 0; j < 4; ++j) *(u32x4*)(KFl + (tid + 256 * j) * 8) = rK[j]; \
            _Pragma("unroll") for (int j = 0; j < 2; ++j) *(u32x4*)(VFl + (tid + 256 * j) * 8) = rV[j]; \
            if (tid < 32) *(f32x4*)(DCl + tid * 4) = rD; \
            bf16x8 qf[4], af[2]; \
            _Pragma("unroll") for (int j = 0; j < 4; ++j) qf[j] = as_bf8(rQ[j]); \
            _Pragma("unroll") for (int j = 0; j < 2; ++j) af[j] = as_bf8(rA[j]); \
            LDS_BARRIER(); \
            if ((s) + 1 < nch) SCAN_LOAD((s) + 1, rK, rV, rQ, rA, rD); \
            f32x4 acc[4]; \
            _Pragma("unroll") for (int nb = 0; nb < 4; ++nb) acc[nb] = (f32x4){0.f, 0.f, 0.f, 0.f}; \
            { bf16x8 fr_[8]; \
              _Pragma("unroll") for (int pp = 0; pp < 2; ++pp) _Pragma("unroll") for (int nb = 0; nb < 4; ++nb) fr_[pp * 4 + nb] = *(const bf16x8*)(VFl + ((nb * 2 + pp) * 64 + lane) * 8); \
              _Pragma("unroll") for (int pp = 0; pp < 2; ++pp) _Pragma("unroll") for (int nb = 0; nb < 4; ++nb) acc[nb] = mfma16(af[pp], fr_[pp * 4 + nb], acc[nb]); } \
            _Pragma("unroll") for (int kh = 0; kh < 2; ++kh) { bf16x8 fr_[8]; \
              _Pragma("unroll") for (int k2 = 0; k2 < 2; ++k2) _Pragma("unroll") for (int nb = 0; nb < 4; ++nb) fr_[k2 * 4 + nb] = *(const bf16x8*)(HB + ((nb * 4 + kh * 2 + k2) * 64 + lane) * 8); \
              _Pragma("unroll") for (int k2 = 0; k2 < 2; ++k2) _Pragma("unroll") for (int nb = 0; nb < 4; ++nb) acc[nb] = mfma16(qf[kh * 2 + k2], fr_[k2 * 4 + nb], acc[nb]); } \
            {     \
                _Pragma("unroll") for (int nb = 0; nb < 4; ++nb) \
                    _Pragma("unroll") for (int r = 0; r < 4; ++r) OSl[(quad * 4 + r) * 72 + nb * 16 + l15] = f2bf(acc[nb][r]); \
                bf16_t* op = OF + (size_t)dir * T * 1024 + (size_t)((gch0 + c) * 64 + w * 16) * 1024 + head * 256 + s4 * 64; \
                _Pragma("unroll") for (int j = 0; j < 2; ++j) { const int id_ = lane + 64 * j, row_ = id_ >> 3, ch_ = id_ & 7; \
                    *(u32x4*)(op + (size_t)row_ * 1024 + ch_ * 8) = *(const u32x4*)(OSl + row_ * 72 + ch_ * 8); } \
            } \
            bf16x8 vw[2]; \
            _Pragma("unroll") for (int pp = 0; pp < 2; ++pp) vw[pp] = *(const bf16x8*)(VFl + ((w * 2 + pp) * 64 + lane) * 8); \
            _Pragma("unroll") for (int mh = 0; mh < 2; ++mh) { bf16x8 fr_[8]; f32x4 dc_[4]; \
              _Pragma("unroll") for (int m2 = 0; m2 < 4; ++m2) { _Pragma("unroll") for (int pp = 0; pp < 2; ++pp) fr_[m2 * 2 + pp] = *(const bf16x8*)(KFl + (((mh * 4 + m2) * 2 + pp) * 64 + lane) * 8); \
                                                                  dc_[m2] = *(const f32x4*)(DCl + (mh * 4 + m2) * 16 + quad * 4); } \
              _Pragma("unroll") for (int m2 = 0; m2 < 4; ++m2) { f32x4 a = st[mh * 4 + m2]; \
                _Pragma("unroll") for (int pp = 0; pp < 2; ++pp) a = mfma16(fr_[m2 * 2 + pp], vw[pp], a); \
                st[mh * 4 + m2] = a * dc_[m2]; } } \
            LDS_BARRIER(); \
            _Pragma("unroll") for (int ks = 0; ks < 4; ++ks) { \
                u32x4 o; \
                o.x = pk2(st[2 * ks][0], st[2 * ks][1]); o.y = pk2(st[2 * ks][2], st[2 * ks][3]); \
                o.z = pk2(st[2 * ks + 1][0], st[2 * ks + 1][1]); o.w = pk2(st[2 * ks + 1][2], st[2 * ks + 1][3]); \
                *(u32x4*)(HB + ((w * 4 + ks) * 64 + lane) * 8) = o; \
            } }
        SCAN_LOAD(0, rK0, rV0, rQ0, rA0, rD0);
        for (int s = 0; s < nch; ++s) {
            SCAN_STEP(s, rK0, rV0, rQ0, rA0, rD0);
        }
#undef SCAN_STEP
#undef SCAN_LOAD
        if (!lat) {
            float* sp = p.out + OUT_STATE + (((size_t)b * 2 + dir) * 4 + head) * 32768 + s4 * 64 + w * 16 + l15;
#pragma unroll
            for (int mb = 0; mb < 8; ++mb)
#pragma unroll
                for (int r = 0; r < 4; ++r) sp[(size_t)(mb * 16 + quad * 4 + r) * 256] = st[mb][r];
        }
    }
}

__device__ void gla_post_phase(PRef p, int wv) {
    const int TIDX = otid(wv);
    const int lane = TIDX & 63, w = TIDX >> 6;
    const bf16_t* OF = (const bf16_t*)(p.ws + OFF_OF);
    const bf16_t* R = (const bf16_t*)(p.ws + OFF_R);
    bf16_t* OG = (bf16_t*)(p.ws + OFF_QK);
    float go[16];
#pragma unroll
    for (int e = 0; e < 4; ++e) { const f32x4 g4 = *(const f32x4*)(p.gla_g_out + lane * 16 + e * 4); go[e * 4] = g4[0]; go[e * 4 + 1] = g4[1]; go[e * 4 + 2] = g4[2]; go[e * 4 + 3] = g4[3]; }
    for (int it = blockIdx.x; it < T / 40; it += gridDim.x) {
#pragma unroll
        for (int rr = 0; rr < 5; ++rr) {
            const size_t t = it * 40 + w * 5 + rr;
            const size_t o0 = t * 1024 + lane * 16;
            float v[16];
            float ss = 0.f;
#pragma unroll
            for (int hh = 0; hh < 2; ++hh) {
                const u32x4 a = *(const u32x4*)(OF + o0 + hh * 8), b = *(const u32x4*)(OF + (size_t)T * 1024 + o0 + hh * 8);
#pragma unroll
                for (int e = 0; e < 4; ++e) {
                    v[hh * 8 + e * 2] = bflo(a[e]) + bflo(b[e]);
                    v[hh * 8 + e * 2 + 1] = bfhi(a[e]) + bfhi(b[e]);
                }
            }
#pragma unroll
            for (int e = 0; e < 16; ++e) ss += v[e] * v[e];
#pragma unroll
            for (int o = 8; o; o >>= 1) ss += __shfl_xor(ss, o);
            const float rs = rsqrtf(ss * (1.f / 256.f) + EPS);
#pragma unroll
            for (int hh = 0; hh < 2; ++hh) {
                const u32x4 rv = *(const u32x4*)(R + o0 + hh * 8);
                u32x4 o;
#pragma unroll
                for (int e = 0; e < 4; ++e) {
                    const int i0 = hh * 8 + e * 2;
                    const float g0 = go[i0], g1 = go[i0 + 1];
                    o[e] = pk2(v[i0] * rs * g0 * silu_f(bflo(rv[e])), v[i0 + 1] * rs * g1 * silu_f(bfhi(rv[e])));
                }
                *(u32x4*)(OG + o0 + hh * 8) = o;
            }
        }
    }
}

__device__ __forceinline__ int kv_row_of(int t) {
    if (t < T_CTX) return t;
    const int b = (t - T_CTX) >> 12, s = (t - T_CTX) & 4095;
    return T_CTX + b * 4352 + 256 + s;
}

__device__ void mla_row_phase(PRef p, int wv) {
    const int TIDX = otid(wv);
    const int lane = TIDX & 63, w = TIDX >> 6;
    const float* PM = (const float*)(p.ws + OFF_PM);
    bf16_t* CQN = (bf16_t*)(p.ws + OFF_CQN);
    bf16_t* CKV = (bf16_t*)(p.ws + OFF_CKV);
    bf16_t* KR = (bf16_t*)(p.ws + OFF_KR);
    const float* rope = (const float*)(p.ws + OFF_ROPE);
    const int nrows = T + 1024;
    for (int it = blockIdx.x; it < nrows / 32; it += gridDim.x) {
#pragma unroll
        for (int rr = 0; rr < 4; ++rr) {
            const int t = it * 32 + w * 4 + rr;
            if (t >= T) {
                const int j = t - T, b = j >> 8, s = j & 255;
                const int kvr = T_CTX + b * 4352 + s;
                const f32x4 v = *(const f32x4*)(p.cache_ckv + (size_t)j * 256 + lane * 4);
                *(u32x2*)(CKV + (size_t)kvr * 256 + lane * 4) = pk4(v);
                KR[(size_t)kvr * 64 + lane] = f2bf(p.cache_kr[(size_t)j * 64 + lane]);
                continue;
            }
            const float* pr = PM + (size_t)t * 832;
            const int kvr = kv_row_of(t);
            {
                const f32x4 a = *(const f32x4*)(pr + lane * 8), b = *(const f32x4*)(pr + lane * 8 + 4);
                float ss = a[0] * a[0] + a[1] * a[1] + a[2] * a[2] + a[3] * a[3] + b[0] * b[0] + b[1] * b[1] + b[2] * b[2] + b[3] * b[3];
                ss = wave_sum(ss);
                const float rs = rsqrtf(ss * (1.f / 512.f) + EPS);
                const f32x4 ga = *(const f32x4*)(p.mla_g_q + lane * 8), gb = *(const f32x4*)(p.mla_g_q + lane * 8 + 4);
                u32x4 o;
                o.x = pk2(a[0] * rs * ga[0], a[1] * rs * ga[1]); o.y = pk2(a[2] * rs * ga[2], a[3] * rs * ga[3]);
                o.z = pk2(b[0] * rs * gb[0], b[1] * rs * gb[1]); o.w = pk2(b[2] * rs * gb[2], b[3] * rs * gb[3]);
                *(u32x4*)(CQN + (size_t)t * 512 + lane * 8) = o;
            }
            {
                const f32x4 a = *(const f32x4*)(pr + 512 + lane * 4);
                float ss = a[0] * a[0] + a[1] * a[1] + a[2] * a[2] + a[3] * a[3];
                ss = wave_sum(ss);
                const float rs = rsqrtf(ss * (1.f / 256.f) + EPS);
                const f32x4 g = *(const f32x4*)(p.mla_g_kv + lane * 4);
                const f32x4 n = a * rs * g;
                *(u32x2*)(CKV + (size_t)kvr * 256 + lane * 4) = pk4(n);
                if (t < T_CTX) *(f32x4*)(p.out + OUT_CKV + (size_t)t * 256 + lane * 4) = n;
            }
            {
                float v = pr[768 + lane];
                if (t < T_CTX) {
                    p.out[OUT_KR + (size_t)t * 64 + lane] = v;
                } else {
                    const int s = (t - T_CTX) & 4095;
                    const int pos = (lane & 32) ? (s & 63) : (s >> 6);
                    const int f = lane & 15;
                    const float cs = rope[(pos * 16 + f) * 2], sn = rope[(pos * 16 + f) * 2 + 1];
                    const float o = __shfl_xor(v, 16);
                    v = (lane & 16) ? (v * cs + o * sn) : (v * cs - o * sn);
                }
                KR[(size_t)kvr * 64 + lane] = f2bf(v);
            }
        }
    }
}

__device__ __forceinline__ void mla_attn_item(PRef p, int qrow0, int head, int kt0, int ntiles, int krow0, char* lds, bool dry, int wv) {
    const int TIDX = otid(wv);
    const int tid = TIDX, lane = tid & 63, w = tid >> 6, l15 = lane & 15, quad = lane >> 4;
    bf16_t* Q = (bf16_t*)(p.ws + OFF_Q);
    const bf16_t* KN = (const bf16_t*)(p.ws + OFF_KN);
    const bf16_t* KR = (const bf16_t*)(p.ws + OFF_KR);
    const bf16_t* VT = (const bf16_t*)(p.ws + OFF_MVT);
    bf16x8 qf[2][6];
#pragma unroll
    for (int nb = 0; nb < 2; ++nb)
#pragma unroll
        for (int ks = 0; ks < 6; ++ks)
            qf[nb][ks] = *(const bf16x8*)(Q + (size_t)(qrow0 + w * 32 + nb * 16 + l15) * 3072 + head * 192 + ks * 32 + quad * 8);
    f32x4 o[8][2];
#pragma unroll
    for (int i = 0; i < 8; ++i) { o[i][0] = (f32x4){0.f, 0.f, 0.f, 0.f}; o[i][1] = (f32x4){0.f, 0.f, 0.f, 0.f}; }
    float mrow[2] = {0.f, 0.f}, lsum[2] = {0.f, 0.f};
    const int wvu = __builtin_amdgcn_readfirstlane(w);
    const char* ksrc[3]; int kstep_[3];
#pragma unroll
    for (int j = 0; j < 3; ++j) {
        const int q = (j * 8 + wvu) * 64 + lane;
        const int row = q / 24, cp = q - row * 24;
        const int c = (cp & 24) | ((cp ^ row) & 7);
        if (c < 16) { ksrc[j] = (const char*)(KN + (size_t)(kt0 * 64 + row) * 2048 + head * 128 + c * 8); kstep_[j] = 64 * 2048 * 2; }
        else        { ksrc[j] = (const char*)(KR + (size_t)(krow0 + row) * 64 + (c - 16) * 8); kstep_[j] = 64 * 64 * 2; }
    }
    const char* vsrc = (const char*)(VT + ((size_t)kt0 * 16 + head) * 8192 + (size_t)(wvu * 64 + lane) * 8);
    LAS unsigned char* ldsl = (LAS unsigned char*)lds;
    const int kb0 = l15 * 384 + ((quad ^ (l15 & 7)) << 4), kb1 = l15 * 384 + (((quad ^ (l15 & 7)) ^ 4) << 4);
#define ATT_STAGE(tile, buf) { \
    _Pragma("unroll") for (int j = 0; j < 3; ++j) \
        __builtin_amdgcn_global_load_lds((const unsigned*)(ksrc[j] + (size_t)(tile) * kstep_[j]), (LAS unsigned*)(ldsl + (buf) * 40960 + (j * 8 + wvu) * 1024), 16, 0, 0); \
    _Pragma("unroll") for (int j = 0; j < 2; ++j) \
        __builtin_amdgcn_global_load_lds((const unsigned*)(vsrc + (size_t)(tile) * (16 * 8192 * 2) + j * 8192), (LAS unsigned*)(ldsl + (buf) * 40960 + 24576 + (j * 8 + wvu) * 1024), 16, 0, 0); }
    __syncthreads();
    ATT_STAGE(0, 0);
    asm volatile("s_waitcnt vmcnt(0)" ::: "memory");
    __syncthreads();
    for (int tl = 0; tl < ntiles; ++tl) {
        const char* Kb = lds + (tl & 1) * 40960;
        const char* Vb = Kb + 24576;
        if (tl + 1 < ntiles) ATT_STAGE(tl + 1, (tl + 1) & 1);
        f32x4 s[2][2][2];
#pragma unroll
        for (int hk = 0; hk < 2; ++hk)
#pragma unroll
            for (int mb = 0; mb < 2; ++mb) { s[hk][mb][0] = (f32x4){-mrow[0], -mrow[0], -mrow[0], -mrow[0]}; s[hk][mb][1] = (f32x4){-mrow[1], -mrow[1], -mrow[1], -mrow[1]}; }
#pragma unroll
        for (int hk = 0; hk < 2; ++hk)
#pragma unroll
            for (int mb = 0; mb < 2; ++mb) {
                bf16x8 kf[6];
#pragma unroll
                for (int ks = 0; ks < 6; ++ks) kf[ks] = *(const bf16x8*)(Kb + hk * 12288 + ((ks & 1) ? kb1 : kb0) + mb * 6144 + (ks >> 1) * 128);
#pragma unroll
                for (int ks = 0; ks < 6; ++ks) {
                    s[hk][mb][0] = mfma16(kf[ks], qf[0][ks], s[hk][mb][0]);
                    s[hk][mb][1] = mfma16(kf[ks], qf[1][ks], s[hk][mb][1]);
                }
            }
        float mxt[2] = {-1e30f, -1e30f};
#pragma unroll
        for (int hk = 0; hk < 2; ++hk) {
            bf16x8 pf[2];
#pragma unroll
            for (int nb = 0; nb < 2; ++nb) {
                const float mx = fmaxf(fmaxf(fmaxf(s[hk][0][nb][0], s[hk][0][nb][1]), fmaxf(s[hk][0][nb][2], s[hk][0][nb][3])), fmaxf(fmaxf(s[hk][1][nb][0], s[hk][1][nb][1]), fmaxf(s[hk][1][nb][2], s[hk][1][nb][3])));
                mxt[nb] = fmaxf(mxt[nb], mx);
                float ps = 0.f;
#pragma unroll
                for (int mb = 0; mb < 2; ++mb)
#pragma unroll
                    for (int r = 0; r < 4; ++r) { const float pv = __builtin_amdgcn_exp2f(s[hk][mb][nb][r]); s[hk][mb][nb][r] = pv; ps += pv; }
                lsum[nb] += ps;
                u32x4 pk;
                pk.x = pk2(s[hk][0][nb][0], s[hk][0][nb][1]); pk.y = pk2(s[hk][0][nb][2], s[hk][0][nb][3]);
                pk.z = pk2(s[hk][1][nb][0], s[hk][1][nb][1]); pk.w = pk2(s[hk][1][nb][2], s[hk][1][nb][3]);
                pf[nb] = as_bf8(pk);
            }
#pragma unroll
            for (int ih = 0; ih < 2; ++ih) {
                bf16x8 vf[4];
#pragma unroll
                for (int i2 = 0; i2 < 4; ++i2) vf[i2] = *(const bf16x8*)(Vb + (((ih * 4 + i2) * 2 + hk) * 64 + lane) * 16);
#pragma unroll
                for (int i2 = 0; i2 < 4; ++i2) {
                    o[ih * 4 + i2][0] = mfma16(vf[i2], pf[0], o[ih * 4 + i2][0]);
                    o[ih * 4 + i2][1] = mfma16(vf[i2], pf[1], o[ih * 4 + i2][1]);
                }
            }
        }
#pragma unroll
        for (int nb = 0; nb < 2; ++nb) {
            float mx = mxt[nb];
            const auto r16 = __builtin_amdgcn_permlane16_swap(__float_as_uint(mx), __float_as_uint(mx), false, false);
            mx = fmaxf(__uint_as_float(r16[0]), __uint_as_float(r16[1]));
            const auto r32 = __builtin_amdgcn_permlane32_swap(__float_as_uint(mx), __float_as_uint(mx), false, false);
            mx = fmaxf(__uint_as_float(r32[0]), __uint_as_float(r32[1]));
            if (__builtin_amdgcn_ballot_w64(mx > 8.0f) != 0) {
                const float delta = fmaxf(mx, 0.f);
                const float alpha = __builtin_amdgcn_exp2f(-delta);
                mrow[nb] += delta;
                lsum[nb] *= alpha;
#pragma unroll
                for (int i = 0; i < 8; ++i) o[i][nb] *= alpha;
            }
        }
        asm volatile("s_waitcnt vmcnt(0)" ::: "memory");
        __syncthreads();
    }
#undef ATT_STAGE
#pragma unroll
    for (int nb = 0; nb < 2; ++nb) {
        float l = lsum[nb];
        l += __shfl_xor(l, 16);
        l += __shfl_xor(l, 32);
        const float inv = 1.f / l;
        bf16_t* op = Q + (size_t)(qrow0 + w * 32 + nb * 16 + l15) * 3072 + head * 192 + quad * 4;
        if (dry && p.out != nullptr) continue;
#pragma unroll
        for (int i = 0; i < 8; ++i) *(u32x2*)(op + i * 16) = pk4(o[i][nb] * inv);
    }
}

__device__ void mla_attn_phase(PRef p, int g, char* lds, int wv, bool dry = false) {
    const int nlat = 2 * 16 * 16, nctx = g == 0 ? 16 * 16 : 0;
    for (int it = blockIdx.x; it < nlat + nctx; it += gridDim.x) {
        int qrow0, head, kt0, ntiles, krow0;
        if (it < nlat) {
            const int rnd = it >> 8, c = it & 255, xcd = c & 7, slot = c >> 3;
            const int pair = rnd * 16 + xcd + 8 * (slot >> 4), qb = slot & 15;
            const int bl = pair >> 4;
            const int b = g * 2 + bl;
            head = pair & 15;
            qrow0 = (g == 0 ? T_CTX : 0) + bl * 4096 + qb * 256;
            krow0 = T_CTX + b * 4352;
            kt0 = (krow0 - (g == 0 ? 0 : 12800)) >> 6;
            ntiles = 68;
        } else {
            const int u = it - nlat, b = u >> 4;
            head = u & 15;
            qrow0 = b * 256; kt0 = b * 4; ntiles = 4; krow0 = b * 256;
        }
        mla_attn_item(p, qrow0, head, kt0, ntiles, krow0, lds, dry, wv);
    }
}

#define XB_TMO      128
#define XB_XCNT(j)  (256  + 64 * (j))
#define XB_XSUB(j)  (1280 + 64 * (j))
#define XB_XGEN(j)  (2304 + 64 * (j))
#define XB_TOP      3328
#define XB_TOPGEN   3392
#define XB_SPIN_CAP (1u << 18)
__device__ __forceinline__ unsigned xb_ld(unsigned* p)              { return __hip_atomic_load(p, __ATOMIC_RELAXED, __HIP_MEMORY_SCOPE_AGENT); }
__device__ __forceinline__ unsigned xb_add(unsigned* p, unsigned v) { return __hip_atomic_fetch_add(p, v, __ATOMIC_RELAXED, __HIP_MEMORY_SCOPE_AGENT); }
__device__ __forceinline__ unsigned xb_xcc_id() { return (unsigned)__builtin_amdgcn_s_getreg((3 << 11) | 20) & 0xFu; }
#define XB_SPIN(cond, bar) do { unsigned _sp = 0; while (cond) { __builtin_amdgcn_s_sleep(1); \
    if ((++_sp & 255u) == 0u) { if (xb_ld(&(bar)[XB_TMO])) break; if (_sp > XB_SPIN_CAP) { atomicAdd(&(bar)[XB_TMO], 1u); break; } } } } while (0)
__device__ __forceinline__ void xcd_barrier_complete(unsigned* bar, unsigned x, unsigned& nloc, unsigned& nx) {
    const unsigned G = gridDim.x;
    unsigned sum, cnt, mine, sp = 0u;
    for (;;) {
        sum = 0u; cnt = 0u; mine = 0u;
#pragma unroll
        for (unsigned j = 0; j < 16; ++j) { const unsigned c = xb_ld(&bar[XB_XCNT(j)]); sum += c; cnt += (c > 0u) ? 1u : 0u; mine = (j == x) ? c : mine; }
        if (sum == G) break;
        __builtin_amdgcn_s_sleep(1);
        if ((++sp & 255u) == 0u) { if (xb_ld(&bar[XB_TMO])) break; if (sp > XB_SPIN_CAP) { atomicAdd(&bar[XB_TMO], 1u); break; } }
    }
    nloc = mine > 0u ? mine : 1u; nx = cnt > 0u ? cnt : 1u;
}
__device__ __forceinline__ void xcd_barrier(unsigned* bar, volatile LAS unsigned* st, int wv) {
    asm volatile("s_waitcnt vmcnt(0)" ::: "memory");
    __syncthreads();
    if (otid(wv) == 0) {
        const unsigned x = xb_xcc_id();
        __builtin_amdgcn_s_waitcnt(0);
        unsigned nloc = st[0], nx = st[1];
        if (nloc == 0u) { xcd_barrier_complete(bar, x, nloc, nx); st[0] = nloc; st[1] = nx; }
        const unsigned old = xb_add(&bar[XB_XSUB(x)], 1u);
        const unsigned gen = old / nloc;
        if (old + 1u == (gen + 1u) * nloc) {
            __builtin_amdgcn_fence(__ATOMIC_RELEASE, "agent");
            asm volatile("s_waitcnt vmcnt(0)" ::: "memory");
            const unsigned og = xb_add(&bar[XB_TOP], 1u);
            const unsigned tg = og / nx;
            if (og + 1u == (tg + 1u) * nx) xb_add(&bar[XB_TOPGEN], 1u);
            else XB_SPIN(xb_ld(&bar[XB_TOPGEN]) == tg, bar);
            __builtin_amdgcn_fence(__ATOMIC_ACQUIRE, "agent");
            xb_add(&bar[XB_XGEN(x)], 1u);
            asm volatile("s_waitcnt vmcnt(0)" ::: "memory");
        } else {
            XB_SPIN(xb_ld(&bar[XB_XGEN(x)]) == gen, bar);
            __builtin_amdgcn_fence(__ATOMIC_ACQUIRE, "agent");
            asm volatile("s_waitcnt vmcnt(0)" ::: "memory");
        }
    }
    __syncthreads();
}

__device__ __forceinline__ const __attribute__((address_space(4))) Params* kparams() {
    const __attribute__((address_space(4))) Params* kp = (const __attribute__((address_space(4))) Params*)__builtin_amdgcn_kernarg_segment_ptr();
    asm volatile("" : "+s"(kp));
    return kp;
}
__device__ const unsigned char PROG[29][2] = {
    {0, 0}, {1, 0}, {2, 0}, {3, 0}, {1, 1}, {4, 0}, {5, 0}, {6, 0}, {7, 0}, {8, 0}, {1, 2}, {2, 1}, {3, 1},
    {1, 3}, {2, 0}, {3, 0}, {1, 4}, {9, 0}, {10, 0}, {11, 0}, {12, 0}, {13, 0}, {11, 1}, {12, 1}, {13, 1}, {1, 5}, {2, 1}, {3, 1}, {1, 6}};

__global__ void __launch_bounds__(512, 2) fwd_megakernel(Params p) {
    cg::grid_group grid = cg::this_grid();
    extern __shared__ __attribute__((aligned(16))) unsigned char lds_raw[];
    char* lds = (char*)lds_raw;
    LAS unsigned char* ldsl = (LAS unsigned char*)lds_raw;
    (void)p;
#define KP (*kparams())
    const int wv = __builtin_amdgcn_readfirstlane(threadIdx.x >> 6);
    volatile LAS unsigned* st = (volatile LAS unsigned*)(ldsl + 131072);
    { unsigned* bar0 = (unsigned*)(KP.ws + OFF_BAR); const unsigned xcc0 = xb_xcc_id();
      if (threadIdx.x == 0) { st[0] = 0u; st[1] = 0u; st[2] = 0u; st[3] = 0u; (void)xb_add(&bar0[XB_XCNT(xcc0)], 1u); } }
    __syncthreads();
#pragma clang loop unroll(disable)
    for (int pc = 0; pc < 29; ++pc) {
        const int op = __builtin_amdgcn_readfirstlane(PROG[pc][0]), arg = __builtin_amdgcn_readfirstlane(PROG[pc][1]);
        switch (op) {
        case 0: break;
        case 1: {
            const int s = arg, l = s / 3, i = s % 3;
            const int ip = s == 0 ? -1 : (s - 1) % 3, lp = s == 0 ? 0 : (s - 1) / 3;
            row_phase(KP, lp, ip, ip == 1 ? 1.0f : 0.5f, l, s == 6 ? -1 : i, s <= 1, wv, false);
        } break;
        case 2: ffn_in_phase(KP, arg == 0 ? WO_FI0 : WO_FI1, ldsl, wv); break;
        case 3: ffn_out_phase(KP, arg == 0 ? WO_FO0 : WO_FO1, ldsl, wv); break;
        case 4: gla_in_phase(KP, ldsl, wv); break;
        case 5: gla_gate_phase(KP, lds, wv); break;
        case 6: gla_scan_phase(KP, lds, wv); break;
        case 7: gla_post_phase(KP, wv); break;
        case 8: gla_out_phase(KP, ldsl, wv); break;
        case 9: mla_in_phase(KP, ldsl, wv); break;
        case 10: mla_row_phase(KP, wv); break;
        case 11: mla_proj_phase(KP, arg == 0 ? 0 : 12288, arg == 0 ? 12288 : 8192, arg == 0 ? 0 : 12800, arg == 0 ? 12800 : 8704, ldsl, wv); break;
        case 12: mla_attn_phase(KP, arg, lds, wv, false); break;
        default: mla_out_phase(KP, arg == 0 ? 0 : 12288, arg == 0 ? 12288 : 8192, ldsl, wv); break;
        }
        if (pc == 0 || pc == 12) mods_phase(KP, pc == 0 ? 0 : 1, lds, wv);
        {
            int cl = 0, cm = 0, cf = 0, cn = 1 << 20;
            if (pc == 0) { cl = 0; cm = 0x03; cf = 0; }
            else if (pc == 3) { cl = 0; cm = 0x3c; cf = 64; }
            else if (pc == 7) { cl = 1; cm = 0x03; cf = 0; cn = 128; }
            else if (pc == 12) { cl = 1; cm = 0xf4; cf = 64; }
            else if (pc == 13) { cl = 1; cm = 0x08; cf = 0; }
            if (cm) conv_phase(KP, cl, cm, cf, cn, lds, wv);
        }
        if (pc == 28) break;
        if (KP.out == nullptr) grid.sync();
        xcd_barrier((unsigned*)(KP.ws + OFF_BAR), st, wv);
    }
}

extern "C" void kernel_launch(void* const* d_in, const int* in_sizes, int n_in, void* d_out, int out_size, void* d_ws, size_t ws_size, hipStream_t stream) {
    static int grid_blocks = 0;
    if (!grid_blocks) {
        int dev = 0, cus = 0, per_cu = 0;
        (void)hipGetDevice(&dev);
        (void)hipDeviceGetAttribute(&cus, hipDeviceAttributeMultiprocessorCount, dev);
        if (hipFuncSetAttribute((const void*)fwd_megakernel, hipFuncAttributeMaxDynamicSharedMemorySize, LDS_BYTES) != hipSuccess) fprintf(stderr, "hipFuncSetAttribute failed\n");
        (void)hipOccupancyMaxActiveBlocksPerMultiprocessor(&per_cu, fwd_megakernel, NT, LDS_BYTES);
        if (per_cu > 1) per_cu = 1;
        if (per_cu < 1) per_cu = 1;
        grid_blocks = cus * per_cu;
        if (ws_size < WS_NEED) fprintf(stderr, "workspace too small: %zu < %zu\n", ws_size, (size_t)WS_NEED);
    }
    Params p{};
    const float** pp = (const float**)&p;
    for (int i = 0; i < 23; ++i) pp[i] = (const float*)d_in[i];
    p.out = (float*)d_out;
    p.ws = (char*)d_ws;
    (void)hipMemsetAsync((char*)d_ws + OFF_MODS, 0, SZ_MODS + SZ_BAR, stream);
    void* args[] = {&p};
    hipError_t e = hipLaunchCooperativeKernel((void*)fwd_megakernel, dim3(grid_blocks), dim3(NT), args, LDS_BYTES, stream);
    if (e != hipSuccess) fprintf(stderr, "cooperative launch failed: %s (grid %d)\n", hipGetErrorString(e), grid_blocks);
}
```
